# Optimizing an MI355X kernel written in HIP

```python
import math
import jax, jax.numpy as jnp
from jax import lax
import numpy as np

D_MODEL = 2048
BATCH = 2
SEQ = 16384
DEPTH = 4

N_MIXERS = 3
D_FF = 5632
N_MOD = 9
NORM_EPS = 1e-6

SSM_GROUP = 16
SSM_GROUPS = D_MODEL // SSM_GROUP
SSM_STATE = 64
SSM_CHUNK = 128
SSM_DT_MIN = 1e-3
SSM_DT_MAX = 1e-1

GLA_HEADS = 4
GLA_DK = D_MODEL // 2
GLA_DV = D_MODEL
GLA_DKH = GLA_DK // GLA_HEADS
GLA_DVH = GLA_DV // GLA_HEADS
GLA_RANK = 16
GLA_TAU = 16.0
GLA_CHUNK = 64

DSA_PATTERNS = ((128, 1), (512, 4), (2048, 16))
DSA_GROUPS = 3
DSA_HEADS = 8
DSA_HEAD_DIM = 128
DSA_QKV = 3 * DSA_GROUPS * DSA_HEADS * DSA_HEAD_DIM
DSA_OUT = DSA_HEADS * DSA_HEAD_DIM
DSA_QBLOCK = 128
ROPE_THETA = 10000.0

kernel_name = "hybrid_s5_gla_dilated_macaron_encoder"


def _rms(x):
    xf = x.astype(jnp.float32)
    return xf * lax.rsqrt(jnp.mean(xf * xf, axis=-1, keepdims=True) + NORM_EPS)


def _modulate(x, g, shift, scale):
    h = _rms(x).astype(x.dtype) * g
    return h * (1 + scale) + shift


def _swiglu(h, wi, wo):
    g, u = jnp.split(h @ wi, 2, axis=-1)
    return (jax.nn.silu(g) * u) @ wo


def _cmul(ar, ai, br, bi):
    return ar * br - ai * bi, ar * bi + ai * br


def _s5_direction(ug, lam_re, lam_im, log_dt, b_re, b_im, c_re, c_im):
    bsz, L = ug.shape[0], ug.shape[1]
    G, K, P = SSM_GROUPS, SSM_GROUP, SSM_STATE
    lr = lam_re.astype(jnp.float32)
    li = lam_im.astype(jnp.float32)
    dt = jnp.exp(log_dt.astype(jnp.float32))[:, None]
    mag = jnp.exp(lr * dt)
    ar, ai = mag * jnp.cos(li * dt), mag * jnp.sin(li * dt)
    den = lr * lr + li * li
    fr = ((ar - 1.0) * lr + ai * li) / den
    fi = (ai * lr - (ar - 1.0) * li) / den
    bbr, bbi = _cmul(fr[..., None], fi[..., None],
                     b_re.astype(jnp.float32), b_im.astype(jnp.float32))
    cr_w, ci_w = c_re.astype(jnp.float32), c_im.astype(jnp.float32)
    n_chunk = L // SSM_CHUNK
    uc = ug.reshape(bsz, n_chunk, SSM_CHUNK, G, K).transpose(1, 2, 0, 3, 4)
    a_r = jnp.broadcast_to(ar, (SSM_CHUNK, bsz, G, P))
    a_i = jnp.broadcast_to(ai, (SSM_CHUNK, bsz, G, P))

    def combine(e1, e2):
        a1r, a1i, b1r, b1i = e1
        a2r, a2i, b2r, b2i = e2
        nar, nai = _cmul(a2r, a2i, a1r, a1i)
        nbr, nbi = _cmul(a2r, a2i, b1r, b1i)
        return (nar, nai, nbr + b2r, nbi + b2i)

    def step(carry, u_t):
        hr, hi = carry
        bur = jnp.einsum('tbgk,gpk->tbgp', u_t, bbr)
        bui = jnp.einsum('tbgk,gpk->tbgp', u_t, bbi)
        pr, pi, sr, si = lax.associative_scan(combine, (a_r, a_i, bur, bui), axis=0)
        cr, ci = _cmul(pr, pi, hr[None], hi[None])
        sr = sr + cr
        si = si + ci
        y = jnp.einsum('tbgp,gkp->tbgk', sr, cr_w) - jnp.einsum('tbgp,gkp->tbgk', si, ci_w)
        return (sr[-1], si[-1]), y

    init = (jnp.zeros((bsz, G, P), jnp.float32), jnp.zeros((bsz, G, P), jnp.float32))
    _, y = lax.scan(step, init, uc)
    return y.transpose(2, 0, 1, 3, 4).reshape(bsz, L, G * K)


def _s5_mixer(h, w_in, lam_re, lam_im, log_dt, b_re, b_im, c_re, c_im, d_skip, w_out):
    bsz, L, _ = h.shape
    u = h @ w_in
    ug = u.astype(jnp.float32).reshape(bsz, L, SSM_GROUPS, SSM_GROUP)
    y_f = _s5_direction(ug, lam_re[0], lam_im[0], log_dt[0], b_re[0], b_im[0], c_re[0], c_im[0])
    y_b = jnp.flip(_s5_direction(jnp.flip(ug, 1), lam_re[1], lam_im[1], log_dt[1],
                                 b_re[1], b_im[1], c_re[1], c_im[1]), 1)
    y = y_f + y_b + d_skip.astype(jnp.float32) * u.astype(jnp.float32)
    y = jax.nn.gelu(y).astype(h.dtype)
    a, g = jnp.split(y @ w_out, 2, axis=-1)
    return a * jax.nn.sigmoid(g)


def _gla_direction(q, k, v, logg, strict):
    bsz, L, H, dk = q.shape
    dv = v.shape[-1]
    n = L // GLA_CHUNK

    def chunks(t):
        return t.reshape(bsz, n, GLA_CHUNK, H, t.shape[-1]).transpose(1, 0, 3, 2, 4)

    qc, kc, vc, gc = chunks(q), chunks(k), chunks(v), chunks(logg)
    bc = jnp.cumsum(gc, axis=3)
    t_idx = jnp.arange(GLA_CHUNK)
    mask = (t_idx[:, None] > t_idx[None, :]) if strict else (t_idx[:, None] >= t_idx[None, :])

    def step(S, inp):
        q_, k_, v_, b_ = inp
        qd = q_ * jnp.exp(b_)
        kd = k_ * jnp.exp(-b_)
        att = jnp.where(mask, jnp.einsum('bhtk,bhsk->bhts', qd, kd), 0.0)
        o = jnp.einsum('bhts,bhsv->bhtv', att, v_) + jnp.einsum('bhtk,bhkv->bhtv', qd, S)
        b_last = b_[:, :, -1:, :]
        kl = k_ * jnp.exp(b_last - b_)
        S = jnp.exp(b_last[:, :, 0, :])[..., None] * S + jnp.einsum('bhsk,bhsv->bhkv', kl, v_)
        return S, o

    S0 = jnp.zeros((bsz, H, dk, dv), jnp.float32)
    _, o = lax.scan(step, S0, (qc, kc, vc, bc))
    return o.transpose(1, 0, 3, 2, 4).reshape(bsz, L, H, dv)


def _gla_mixer(h, w_in, w_gate, b_gate, norm_g, w_o):
    bsz, L, _ = h.shape
    proj = h @ w_in
    q, k, v, r, glr = jnp.split(proj, [GLA_DK, 2 * GLA_DK, 2 * GLA_DK + GLA_DV,
                                       2 * GLA_DK + 2 * GLA_DV], axis=-1)
    q = q.astype(jnp.float32).reshape(bsz, L, GLA_HEADS, GLA_DKH) * (GLA_DKH ** -0.5)
    k = k.astype(jnp.float32).reshape(bsz, L, GLA_HEADS, GLA_DKH)
    v = v.astype(jnp.float32).reshape(bsz, L, GLA_HEADS, GLA_DVH)

    def log_gate(d):
        gl = glr[..., d * GLA_RANK:(d + 1) * GLA_RANK] @ w_gate[d] + b_gate[d]
        return (jax.nn.log_sigmoid(gl.astype(jnp.float32)) / GLA_TAU).reshape(bsz, L, GLA_HEADS, GLA_DKH)

    o_f = _gla_direction(q, k, v, log_gate(0), False)
    o_b = jnp.flip(_gla_direction(jnp.flip(q, 1), jnp.flip(k, 1), jnp.flip(v, 1),
                                  jnp.flip(log_gate(1), 1), True), 1)
    o = _rms(o_f + o_b) * norm_g.astype(jnp.float32).reshape(GLA_HEADS, GLA_DVH)
    o = o.reshape(bsz, L, GLA_DV).astype(h.dtype) * jax.nn.silu(r)
    return o @ w_o


def _rope_tables(L):
    pos = jnp.arange(L, dtype=jnp.float32)
    inv = ROPE_THETA ** (-jnp.arange(0, DSA_HEAD_DIM, 2, dtype=jnp.float32) / DSA_HEAD_DIM)
    ang = pos[:, None] * inv[None, :]
    return jnp.cos(ang), jnp.sin(ang)


def _apply_rope(x, cos, sin):
    x1, x2 = jnp.split(x, 2, axis=-1)
    c = cos[None, :, None, None, :]
    s = sin[None, :, None, None, :]
    return jnp.concatenate([x1 * c - x2 * s, x2 * c + x1 * s], axis=-1)


def _dilated_mixer(h, w_in, q_norm, k_norm, w_o):
    bsz, L, _ = h.shape
    proj = (h @ w_in).reshape(bsz, L, 3, DSA_GROUPS, DSA_HEADS, DSA_HEAD_DIM)
    cos, sin = _rope_tables(L)
    qn = q_norm.astype(jnp.float32)[:, None, :]
    kn = k_norm.astype(jnp.float32)[:, None, :]
    q = _apply_rope(_rms(proj[:, :, 0]) * qn, cos, sin) * (DSA_HEAD_DIM ** -0.5)
    k = _apply_rope(_rms(proj[:, :, 1]) * kn, cos, sin)
    q = q.astype(h.dtype).transpose(2, 0, 3, 1, 4)
    k = k.astype(h.dtype).transpose(2, 0, 3, 1, 4)
    v = proj[:, :, 2].transpose(2, 0, 3, 1, 4)
    n_blk = L // DSA_QBLOCK

    def block(j):
        t = j * DSA_QBLOCK + jnp.arange(DSA_QBLOCK)
        outs, lses = [], []
        for g, (window, dil) in enumerate(DSA_PATTERNS):
            n_side = window // (2 * dil)
            offs = dil * jnp.arange(-n_side, n_side + 1)
            idx = t[:, None] + offs[None, :]
            valid = (idx >= 0) & (idx < L)
            idxc = jnp.clip(idx, 0, L - 1)
            qb = lax.dynamic_slice_in_dim(q[g], j * DSA_QBLOCK, DSA_QBLOCK, axis=2)
            kg = jnp.take(k[g], idxc, axis=2)
            vg = jnp.take(v[g], idxc, axis=2)
            s = jnp.einsum('bhqd,bhqnd->bhqn', qb, kg).astype(jnp.float32)
            s = jnp.where(valid, s, -1e30)
            m = jnp.max(s, axis=-1, keepdims=True)
            p = jnp.exp(s - m)
            den = jnp.sum(p, axis=-1, keepdims=True)
            o = jnp.einsum('bhqn,bhqnd->bhqd', p.astype(vg.dtype), vg).astype(jnp.float32) / den
            outs.append(o)
            lses.append((m + jnp.log(den))[..., 0])
        w = jax.nn.softmax(jnp.stack(lses, 0), axis=0)
        return jnp.sum(w[..., None] * jnp.stack(outs, 0), axis=0).astype(h.dtype)

    o = lax.map(block, jnp.arange(n_blk))
    o = o.transpose(1, 0, 3, 2, 4).reshape(bsz, L, DSA_OUT)
    return o @ w_o


def setup_inputs(seed: int = 0) -> dict:
    key = jax.random.key(seed)
    ks = iter(jax.random.split(key, 40))
    f32 = jnp.float32
    D, G, P, K = D_MODEL, SSM_GROUPS, SSM_STATE, SSM_GROUP
    n_a = len(range(0, DEPTH, N_MIXERS))
    n_b = len(range(1, DEPTH, N_MIXERS))
    n_c = len(range(2, DEPTH, N_MIXERS))

    def nrm(shape, scale):
        return jax.random.normal(next(ks), shape, f32) * scale

    inp = {}
    inp['x'] = nrm((BATCH, SEQ, D), 1.0)
    inp['c'] = nrm((BATCH, D), 1.0)
    inp['ada_w'] = nrm((DEPTH, D, N_MOD * D), 0.5 * D ** -0.5)
    inp['ada_b'] = nrm((DEPTH, N_MOD * D), 0.02)
    inp['norm_g'] = 1.0 + nrm((DEPTH, 3, D), 0.02)
    inp['ffn1_wi'] = nrm((DEPTH, D, 2 * D_FF), D ** -0.5)
    inp['ffn1_wo'] = nrm((DEPTH, D_FF, D), D_FF ** -0.5)
    inp['ffn2_wi'] = nrm((DEPTH, D, 2 * D_FF), D ** -0.5)
    inp['ffn2_wo'] = nrm((DEPTH, D_FF, D), D_FF ** -0.5)
    inp['ssm_w_in'] = nrm((n_a, D, D), D ** -0.5)
    inp['ssm_lam_re'] = -0.5 + nrm((n_a, 2, G, P), 0.01)
    inp['ssm_lam_im'] = math.pi * jnp.arange(P, dtype=f32) + nrm((n_a, 2, G, P), 0.01)
    inp['ssm_log_dt'] = jax.random.uniform(next(ks), (n_a, 2, G), f32,
                                           math.log(SSM_DT_MIN), math.log(SSM_DT_MAX))
    inp['ssm_b_re'] = nrm((n_a, 2, G, P, K), (2 * K) ** -0.5)
    inp['ssm_b_im'] = nrm((n_a, 2, G, P, K), (2 * K) ** -0.5)
    inp['ssm_c_re'] = nrm((n_a, 2, G, K, P), (2 * P) ** -0.5)
    inp['ssm_c_im'] = nrm((n_a, 2, G, K, P), (2 * P) ** -0.5)
    inp['ssm_d'] = nrm((n_a, D), 1.0)
    inp['ssm_w_out'] = nrm((n_a, D, 2 * D), D ** -0.5)
    inp['gla_w_in'] = nrm((n_b, D, 2 * GLA_DK + 2 * GLA_DV + 2 * GLA_RANK), D ** -0.5)
    inp['gla_w_gate'] = nrm((n_b, 2, GLA_RANK, GLA_DK), GLA_RANK ** -0.5)
    inp['gla_b_gate'] = nrm((n_b, 2, GLA_DK), 0.01)
    inp['gla_norm_g'] = 1.0 + nrm((n_b, GLA_DV), 0.02)
    inp['gla_w_o'] = nrm((n_b, GLA_DV, D), GLA_DV ** -0.5)
    inp['dsa_w_in'] = nrm((n_c, D, DSA_QKV), D ** -0.5)
    inp['dsa_q_norm'] = 1.0 + nrm((n_c, DSA_GROUPS, DSA_HEAD_DIM), 0.02)
    inp['dsa_k_norm'] = 1.0 + nrm((n_c, DSA_GROUPS, DSA_HEAD_DIM), 0.02)
    inp['dsa_w_o'] = nrm((n_c, DSA_OUT, D), DSA_OUT ** -0.5)
    return inp


def reference(x, c, ada_w, ada_b, norm_g, ffn1_wi, ffn1_wo, ffn2_wi, ffn2_wo,
              ssm_w_in, ssm_lam_re, ssm_lam_im, ssm_log_dt, ssm_b_re, ssm_b_im,
              ssm_c_re, ssm_c_im, ssm_d, ssm_w_out,
              gla_w_in, gla_w_gate, gla_b_gate, gla_norm_g, gla_w_o,
              dsa_w_in, dsa_q_norm, dsa_k_norm, dsa_w_o):
    bsz = x.shape[0]
    c_act = jax.nn.silu(c)
    for i in range(DEPTH):
        mod = (c_act @ ada_w[i] + ada_b[i]).reshape(bsz, N_MOD, 1, D_MODEL)
        sh1, sc1, g1 = mod[:, 0], mod[:, 1], mod[:, 2]
        shm, scm, gm = mod[:, 3], mod[:, 4], mod[:, 5]
        sh2, sc2, g2 = mod[:, 6], mod[:, 7], mod[:, 8]
        h = _modulate(x, norm_g[i, 0], sh1, sc1)
        x = x + 0.5 * g1 * _swiglu(h, ffn1_wi[i], ffn1_wo[i])
        h = _modulate(x, norm_g[i, 1], shm, scm)
        kind, j = i % N_MIXERS, i // N_MIXERS
        if kind == 0:
            y = _s5_mixer(h, ssm_w_in[j], ssm_lam_re[j], ssm_lam_im[j], ssm_log_dt[j],
                          ssm_b_re[j], ssm_b_im[j], ssm_c_re[j], ssm_c_im[j], ssm_d[j], ssm_w_out[j])
        elif kind == 1:
            y = _gla_mixer(h, gla_w_in[j], gla_w_gate[j], gla_b_gate[j], gla_norm_g[j], gla_w_o[j])
        else:
            y = _dilated_mixer(h, dsa_w_in[j], dsa_q_norm[j], dsa_k_norm[j], dsa_w_o[j])
        x = x + gm * y
        h = _modulate(x, norm_g[i, 2], sh2, sc2)
        x = x + 0.5 * g2 * _swiglu(h, ffn2_wi[i], ffn2_wo[i])
    return x
```

```cpp
#include <hip/hip_runtime.h>
#include <cstdio>
#include <cstdint>
#include <cmath>
#define XB_TMO      128
#define XB_XCNT(j)  (256  + 64 * (j))
#define XB_XSUB(j)  (1280 + 64 * (j))
#define XB_XGEN(j)  (2304 + 64 * (j))
#define XB_TOP      3328
#define XB_TOPGEN   3392
#define XCD_BAR_WORDS 3456
#define XB_SPIN_CAP (1u << 21)
#define LAS __attribute__((address_space(3)))

__device__ __forceinline__ unsigned xb_ld(unsigned* p)              { return __hip_atomic_load(p, __ATOMIC_RELAXED, __HIP_MEMORY_SCOPE_AGENT); }
__device__ __forceinline__ unsigned xb_add(unsigned* p, unsigned v) { return __hip_atomic_fetch_add(p, v, __ATOMIC_RELAXED, __HIP_MEMORY_SCOPE_AGENT); }
__device__ __forceinline__ unsigned xb_xcc_id() { return (unsigned)__builtin_amdgcn_s_getreg((3 << 11) | 20) & 0xFu; }
#define XB_SPIN(cond, bar) do { unsigned _sp = 0; while (cond) { __builtin_amdgcn_s_sleep(1); \
    if ((++_sp & 255u) == 0u) { if (xb_ld(&(bar)[XB_TMO])) break; if (_sp > XB_SPIN_CAP) { atomicAdd(&(bar)[XB_TMO], 1u); break; } } } } while (0)

struct XcdBarrier {
    unsigned* bar; unsigned x;
    volatile LAS unsigned* st;
};

__device__ __forceinline__ XcdBarrier xcd_barrier_post(unsigned* bar, volatile LAS unsigned* st) {
    XcdBarrier b; b.bar = bar; b.x = xb_xcc_id(); b.st = st;
    if (threadIdx.x == 0) (void)xb_add(&bar[XB_XCNT(b.x)], 1u);
    return b;
}
__device__ __forceinline__ void xcd_barrier_complete(unsigned* bar, unsigned x, unsigned& nloc, unsigned& nx) {
    const unsigned G = gridDim.x * gridDim.y * gridDim.z;
    unsigned sum, cnt, mine, sp = 0u;
    for (;;) {
        sum = 0u; cnt = 0u; mine = 0u;
#pragma unroll
        for (unsigned j = 0; j < 16; ++j) { const unsigned c = xb_ld(&bar[XB_XCNT(j)]); sum += c; cnt += (c > 0u) ? 1u : 0u; mine = (j == x) ? c : mine; }
        if (sum == G) break;
        __builtin_amdgcn_s_sleep(1);
        if ((++sp & 255u) == 0u) { if (xb_ld(&bar[XB_TMO])) break; if (sp > XB_SPIN_CAP) { atomicAdd(&bar[XB_TMO], 1u); break; } }
    }
    nloc = mine > 0u ? mine : 1u; nx = cnt > 0u ? cnt : 1u;
}

__device__ __forceinline__ void xcd_barrier(const XcdBarrier& b) {
    asm volatile("s_waitcnt vmcnt(0)" ::: "memory");
    __syncthreads();
    if (threadIdx.x == 0) {
        unsigned* bar = b.bar;
        __builtin_amdgcn_s_waitcnt(0);
        unsigned nloc = b.st[0], nx = b.st[1];
        if (nloc == 0u) { xcd_barrier_complete(bar, b.x, nloc, nx); b.st[0] = nloc; b.st[1] = nx; }
        const unsigned old = xb_add(&bar[XB_XSUB(b.x)], 1u);
        const unsigned gen = old / nloc;
        if (old + 1u == (gen + 1u) * nloc) {
            __builtin_amdgcn_fence(__ATOMIC_RELEASE, "agent");
            asm volatile("s_waitcnt vmcnt(0)" ::: "memory");
            const unsigned og = xb_add(&bar[XB_TOP], 1u);
            const unsigned tg = og / nx;
            if (og + 1u == (tg + 1u) * nx) xb_add(&bar[XB_TOPGEN], 1u);
            else XB_SPIN(xb_ld(&bar[XB_TOPGEN]) == tg, bar);
            __builtin_amdgcn_fence(__ATOMIC_ACQUIRE, "agent");
            xb_add(&bar[XB_XGEN(b.x)], 1u);
            asm volatile("s_waitcnt vmcnt(0)" ::: "memory");
        } else {
            XB_SPIN(xb_ld(&bar[XB_XGEN(b.x)]) == gen, bar);
            __builtin_amdgcn_fence(__ATOMIC_ACQUIRE, "agent");
            asm volatile("s_waitcnt vmcnt(0)" ::: "memory");
        }
    }
    __syncthreads();
}
namespace pg8 {
#define PG8_LAS __attribute__((address_space(3)))
typedef unsigned short bf16_t;
typedef short bf16x8 __attribute__((ext_vector_type(8)));
typedef float f32x4 __attribute__((ext_vector_type(4)));
typedef unsigned u32x4 __attribute__((ext_vector_type(4)));
constexpr int BM = 256, BK = 64, HALF = 128, HTB = HALF * BK * 2  , STAGE_BYTES = 8 * HTB, NXCD = 8, WGM = 8;

__host__ __device__ __forceinline__ int lds_byte(int r, int c) { const int st = (r >> 4) * 2 + (c >> 5), rr = r & 15, cc = c & 31, ob = rr * 64 + cc * 2; return st * 1024 + (ob ^ (((ob >> 9) & 1) << 5)); }
__host__ __device__ __forceinline__ void stage_rc(int b, int& R, int& C) { const int st = b / 1024, sb = b % 1024, swz = sb ^ (((sb >> 9) & 1) << 5); R = (st >> 1) * 16 + swz / 64; C = (st & 1) * 32 + (swz % 64) / 2; }
__host__ __device__ __forceinline__ int perm32(int rho) { const int n = rho >> 4, i = rho & 15; return 8 * (i >> 2) + 4 * n + (i & 3); }

struct Unit { int pm, pn; };
struct Gemm { const bf16_t* A; const bf16_t* Bt; int M, N, K; };

struct StaticOrder {
    int nM, nN, nwg, G, c;
    __host__ __device__ void init(int M, int N, int G_, int c_) { nM = M / BM; nN = N / BM; nwg = nM * nN; G = G_; c = c_; }
    __host__ __device__ bool next(int i, Unit& u) const {
        const long L = (long)i * G + c; if (L >= nwg) return false;
        int wgid = (int)L; { const int q = nwg / NXCD, r = nwg % NXCD, xcd = wgid % NXCD, off = wgid / NXCD; wgid = (xcd < r ? xcd * (q + 1) : r * (q + 1) + (xcd - r) * q) + off; }
        const int nig = WGM * nN, gid = wgid / nig, fm = gid * WGM, gsz = (nM - fm) < WGM ? (nM - fm) : WGM;
        u.pm = fm + ((wgid % nig) % gsz); u.pn = (wgid % nig) / gsz; return true;
    }
    __device__ __forceinline__ void a_ready(const Unit&) const {}
    __device__ __forceinline__ void done(const Unit&) const {}
};
__device__ __forceinline__ unsigned cvt_pk_bf16(float lo, float hi) { unsigned r; asm volatile("v_cvt_pk_bf16_f32 %0, %1, %2" : "=v"(r) : "v"(lo), "v"(hi)); return r; }
typedef float f32x2 __attribute__((ext_vector_type(2)));
__device__ __forceinline__ float sigmoid_fast(float x) { return __builtin_amdgcn_rcpf(1.0f + __expf(-x)); }
struct EpiSwiGLU {
    static constexpr bool PERM = true, AFTER_DRAIN = false;
    bf16_t* O; int ldc;
    __device__ __forceinline__ void operator()(const f32x4 (&acc)[2][2][4][2], const Unit& u, int wr, int wc, int fr, int fq) const {
        const int row0 = u.pm * BM + wr * 64 + fr, col0 = u.pn * HALF + wc * 32 + 8 * fq;
#pragma unroll
        for (int ai = 0; ai < 2; ++ai)
#pragma unroll
            for (int m = 0; m < 4; ++m) { bf16_t* rowp = O + (size_t)(row0 + ai * HALF + m * 16) * ldc + col0;
                float v[8];
#pragma unroll
                for (int n = 0; n < 2; ++n)
#pragma unroll
                    for (int i = 0; i < 4; ++i) { const float g = acc[ai][0][m][n][i], uu = acc[ai][1][m][n][i]; v[4 * n + i] = g * sigmoid_fast(g) * uu; }
                u32x4 w; w.x = cvt_pk_bf16(v[0], v[1]); w.y = cvt_pk_bf16(v[2], v[3]); w.z = cvt_pk_bf16(v[4], v[5]); w.w = cvt_pk_bf16(v[6], v[7]);
                *(u32x4*)rowp = w; }
    }
};
struct EpiBf16P {
    static constexpr bool PERM = true, AFTER_DRAIN = false;
    bf16_t* O; int ldc;
    __device__ __forceinline__ void operator()(const f32x4 (&acc)[2][2][4][2], const Unit& u, int wr, int wc, int fr, int fq) const {
        const int row0 = u.pm * BM + wr * 64 + fr, col0 = u.pn * BM + wc * 32 + 8 * fq;
#pragma unroll
        for (int ai = 0; ai < 2; ++ai)
#pragma unroll
            for (int m = 0; m < 4; ++m) { bf16_t* rowp = O + (size_t)(row0 + ai * HALF + m * 16) * ldc + col0;
#pragma unroll
                for (int bj = 0; bj < 2; ++bj) { const f32x4 v0 = acc[ai][bj][m][0], v1 = acc[ai][bj][m][1];
                    u32x4 w; w.x = cvt_pk_bf16(v0[0], v0[1]); w.y = cvt_pk_bf16(v0[2], v0[3]); w.z = cvt_pk_bf16(v1[0], v1[1]); w.w = cvt_pk_bf16(v1[2], v1[3]);
                    *(u32x4*)(rowp + bj * HALF) = w; } }
    }
};
struct EpiRes {
    static constexpr bool PERM = false, AFTER_DRAIN = false;
    const float* base; float* out; int ldc; const float* gate; int gate_bstride; float gscale; int rows_per_batch;
    __device__ __forceinline__ void operator()(const f32x4 (&acc)[2][2][4][2], const Unit& u, int wr, int wc, int fr, int fq) const {
        const int row0 = u.pm * BM + wr * 64 + fr, col0 = u.pn * BM + wc * 32 + 4 * fq;
        const float* gp = gate + (size_t)((u.pm * BM) / rows_per_batch) * gate_bstride + col0;
        f32x4 gv[2][2];
#pragma unroll
        for (int bj = 0; bj < 2; ++bj)
#pragma unroll
            for (int n = 0; n < 2; ++n) gv[bj][n] = *(const f32x4*)(gp + bj * HALF + n * 16) * gscale;
#pragma unroll
        for (int ai = 0; ai < 2; ++ai)
#pragma unroll
            for (int m = 0; m < 4; ++m) { const size_t off = (size_t)(row0 + ai * HALF + m * 16) * ldc + col0;
#pragma unroll
                for (int bj = 0; bj < 2; ++bj)
#pragma unroll
                    for (int n = 0; n < 2; ++n) { const f32x4 bs = *(const f32x4*)(base + off + bj * HALF + n * 16);
                        *(f32x4*)(out + off + bj * HALF + n * 16) = bs + gv[bj][n] * acc[ai][bj][m][n]; }
                asm volatile("" ::: "memory"); }
    }
};
struct EpiGLURes {
    static constexpr bool PERM = true, AFTER_DRAIN = false;
    const float* base; float* out; int ldc; const float* gate; int gate_bstride; int rows_per_batch;
    __device__ __forceinline__ void operator()(const f32x4 (&acc)[2][2][4][2], const Unit& u, int wr, int wc, int fr, int fq) const {
        const int row0 = u.pm * BM + wr * 64 + fr, col0 = u.pn * HALF + wc * 32 + 8 * fq;
        const float* gp = gate + (size_t)((u.pm * BM) / rows_per_batch) * gate_bstride + col0;
        const f32x4 gv0 = *(const f32x4*)gp, gv1 = *(const f32x4*)(gp + 4);
#pragma unroll
        for (int ai = 0; ai < 2; ++ai)
#pragma unroll
            for (int m = 0; m < 4; ++m) { const size_t off = (size_t)(row0 + ai * HALF + m * 16) * ldc + col0;
                const f32x4 b0 = *(const f32x4*)(base + off), b1 = *(const f32x4*)(base + off + 4);
                f32x4 y0, y1;
#pragma unroll
                for (int i = 0; i < 4; ++i) { y0[i] = acc[ai][0][m][0][i] * sigmoid_fast(acc[ai][1][m][0][i]); y1[i] = acc[ai][0][m][1][i] * sigmoid_fast(acc[ai][1][m][1][i]); }
                *(f32x4*)(out + off) = b0 + gv0 * y0; *(f32x4*)(out + off + 4) = b1 + gv1 * y1;
                asm volatile("" ::: "memory"); }
    }
};
template <class Epi, class Sched, bool ALIGN_EPI = false, bool SP2 = false>
__device__ __forceinline__ void gemm_phase(PG8_LAS unsigned char* lds, const Gemm g, const Sched& S, const Epi& E, const int tid) {
    const int wid = __builtin_amdgcn_readfirstlane(tid >> 6), lane = tid & 63, wr = wid >> 2, wc = wid & 3, fr = lane & 15, fq = lane >> 4;
    const int K = g.K, nt = K / BK;
    unsigned voffA[2], voffB[2];
#pragma unroll
    for (int i = 0; i < 2; ++i) { int R, C; stage_rc(tid * 16 + i * 8192, R, C); const int Rb = Epi::PERM ? ((R & ~31) + perm32(R & 31)) : R;
        voffA[i] = (unsigned)(R * K + C) * 2u; voffB[i] = (unsigned)(Rb * K + C) * 2u; }
    const size_t kstep = (size_t)(BK * 2);
    const size_t hstep = (size_t)HALF * K * 2;
    const size_t tstep = 2 * hstep;
    const unsigned ldsw = (unsigned)wid * 1024u;
    const int aoff = lds_byte(wr * 64 + fr, fq * 8), boff = lds_byte(wc * 32 + fr, fq * 8);
#define PG8_SA(b, h) (((b) * 2 + (h)) * HTB)
#define PG8_SB(b, h) ((4 + (b) * 2 + (h)) * HTB)
#define PG8_STAGE(bufoff, gbase, voff) do { _Pragma("unroll") for (int _i = 0; _i < 2; ++_i) \
        __builtin_amdgcn_global_load_lds((const unsigned*)((const char*)(gbase) + (voff)[_i]), (PG8_LAS unsigned*)(lds + (bufoff) + ldsw + _i * 8192), 16, 0, 0); } while (0)
#define PG8_LDA(dst, b, h) do { _Pragma("unroll") for (int m = 0; m < 4; ++m) _Pragma("unroll") for (int k = 0; k < 2; ++k) dst[m][k] = *(const PG8_LAS bf16x8*)(lds + PG8_SA(b, h) + aoff + m * 2048 + k * 1024); } while (0)
#define PG8_LDB(dst, b, h) do { _Pragma("unroll") for (int n = 0; n < 2; ++n) _Pragma("unroll") for (int k = 0; k < 2; ++k) dst[n][k] = *(const PG8_LAS bf16x8*)(lds + PG8_SB(b, h) + boff + n * 2048 + k * 1024); } while (0)
#define PG8_MMA(ai, bj, At, Bt) do { __builtin_amdgcn_s_setprio(1); _Pragma("unroll") for (int m = 0; m < 4; ++m) _Pragma("unroll") for (int n = 0; n < 2; ++n) _Pragma("unroll") for (int k = 0; k < 2; ++k) \
        acc[ai][bj][m][n] = __builtin_amdgcn_mfma_f32_16x16x32_bf16(Bt[n][k], At[m][k], acc[ai][bj][m][n], 0, 0, 0); __builtin_amdgcn_s_setprio(0); } while (0)
#define PG8_WAIT_V(n) asm volatile("s_waitcnt vmcnt(" #n ")" ::: "memory")
#define PG8_WAIT_L(n) asm volatile("s_waitcnt lgkmcnt(" #n ")" ::: "memory")
#define PG8_BAR __builtin_amdgcn_s_barrier()
#define PG8_SCHED __builtin_amdgcn_sched_barrier(0)
    Unit cur, nxt; int ui = 0;
    if (!S.next(0, cur)) return;
    f32x4 acc[2][2][4][2];
#pragma unroll
    for (int a = 0; a < 2; ++a)
#pragma unroll
        for (int b = 0; b < 2; ++b)
#pragma unroll
            for (int m = 0; m < 4; ++m)
#pragma unroll
                for (int n = 0; n < 2; ++n) acc[a][b][m][n] = (f32x4){0.f, 0.f, 0.f, 0.f};
    bf16x8 At[4][2], B0[2][2], B1[2][2];
    const char* cA = (const char*)g.A + (size_t)cur.pm * tstep; const char* cB = (const char*)g.Bt + (size_t)cur.pn * tstep;
    S.a_ready(cur);
    if constexpr (SP2) {
        PG8_STAGE(PG8_SB(0, 0), cB, voffB); PG8_STAGE(PG8_SB(0, 1), cB + hstep, voffB); PG8_STAGE(PG8_SA(0, 0), cA, voffA); PG8_STAGE(PG8_SA(0, 1), cA + hstep, voffA);
        if (wr == 1) PG8_BAR;
        PG8_WAIT_V(2); PG8_BAR;
        PG8_STAGE(PG8_SB(1, 0), cB + kstep, voffB); PG8_STAGE(PG8_SA(1, 0), cA + kstep, voffA); PG8_STAGE(PG8_SB(1, 1), cB + hstep + kstep, voffB);
        PG8_WAIT_V(6); PG8_BAR;
    } else {
        PG8_STAGE(PG8_SB(0, 0), cB, voffB); PG8_STAGE(PG8_SA(0, 0), cA, voffA); PG8_STAGE(PG8_SB(0, 1), cB + hstep, voffB); PG8_STAGE(PG8_SA(0, 1), cA + hstep, voffA);
        if (wr == 1) PG8_BAR;
        PG8_WAIT_V(4); PG8_BAR;
        PG8_STAGE(PG8_SB(1, 0), cB + kstep, voffB); PG8_STAGE(PG8_SA(1, 0), cA + kstep, voffA); PG8_STAGE(PG8_SB(1, 1), cB + hstep + kstep, voffB);
        PG8_WAIT_V(6); PG8_BAR;
    }
    for (;;) {
        const bool has_next = S.next(ui + 1, nxt);
        const char* nA = has_next ? (const char*)g.A + (size_t)nxt.pm * tstep : cA; const char* nB = has_next ? (const char*)g.Bt + (size_t)nxt.pn * tstep : cB;
        for (int t = 0; t < nt; t += 2) {
            const bool last = (t == nt - 2);
            const char* a1 = cA + (size_t)(t + 1) * kstep;
            const char* a2 = last ? nA : cA + (size_t)(t + 2) * kstep; const char* b2 = last ? nB : cB + (size_t)(t + 2) * kstep;
            const char* a3 = a2 + kstep; const char* b3 = b2 + kstep;
            if (last && has_next) S.a_ready(nxt);
            if constexpr (SP2) {
            PG8_LDB(B0, 0, 0); PG8_LDB(B1, 0, 1); PG8_SCHED; PG8_LDA(At, 0, 0); PG8_STAGE(PG8_SA(1, 1), a1 + hstep, voffA);
            PG8_WAIT_V(8); PG8_WAIT_L(0); PG8_BAR; PG8_MMA(0, 0, At, B0); PG8_MMA(0, 1, At, B1); PG8_BAR; PG8_SCHED;
            PG8_LDA(At, 0, 1); PG8_STAGE(PG8_SB(0, 0), b2, voffB); PG8_STAGE(PG8_SB(0, 1), b2 + hstep, voffB); PG8_STAGE(PG8_SA(0, 0), a2, voffA);
            PG8_WAIT_V(8); PG8_WAIT_L(0); PG8_BAR; PG8_MMA(1, 0, At, B0); PG8_MMA(1, 1, At, B1); PG8_BAR; PG8_SCHED;
            PG8_LDB(B0, 1, 0); PG8_LDB(B1, 1, 1); PG8_SCHED; PG8_LDA(At, 1, 0); PG8_STAGE(PG8_SA(0, 1), a2 + hstep, voffA);
            PG8_WAIT_V(8); PG8_WAIT_L(0); PG8_BAR; PG8_MMA(0, 0, At, B0); PG8_MMA(0, 1, At, B1); PG8_BAR; PG8_SCHED;
            PG8_LDA(At, 1, 1); PG8_STAGE(PG8_SB(1, 0), b3, voffB); PG8_STAGE(PG8_SB(1, 1), b3 + hstep, voffB); PG8_STAGE(PG8_SA(1, 0), a3, voffA);
            PG8_WAIT_V(8); PG8_WAIT_L(0); PG8_BAR; PG8_MMA(1, 0, At, B0); PG8_MMA(1, 1, At, B1); PG8_BAR; PG8_SCHED;
            } else {
            PG8_LDB(B0, 0, 0); PG8_SCHED; PG8_LDA(At, 0, 0); PG8_STAGE(PG8_SA(1, 1), a1 + hstep, voffA);
            PG8_WAIT_L(8); PG8_BAR; PG8_WAIT_L(0); PG8_MMA(0, 0, At, B0); PG8_BAR; PG8_SCHED;
            PG8_LDB(B1, 0, 1); PG8_STAGE(PG8_SB(0, 0), b2, voffB);
            PG8_BAR; PG8_WAIT_L(0); PG8_MMA(0, 1, At, B1); PG8_BAR;
            PG8_LDA(At, 0, 1); PG8_STAGE(PG8_SA(0, 0), a2, voffA);
            PG8_BAR; PG8_WAIT_L(0); PG8_MMA(1, 0, At, B0); PG8_BAR; PG8_SCHED;
            PG8_STAGE(PG8_SB(0, 1), b2 + hstep, voffB);
            PG8_WAIT_V(6); PG8_BAR; PG8_MMA(1, 1, At, B1); PG8_BAR;
            PG8_LDB(B0, 1, 0); PG8_SCHED; PG8_LDA(At, 1, 0); PG8_STAGE(PG8_SA(0, 1), a2 + hstep, voffA);
            PG8_WAIT_L(8); PG8_BAR; PG8_WAIT_L(0); PG8_MMA(0, 0, At, B0); PG8_BAR; PG8_SCHED;
            PG8_LDB(B1, 1, 1); PG8_STAGE(PG8_SB(1, 0), b3, voffB);
            PG8_BAR; PG8_WAIT_L(0); PG8_MMA(0, 1, At, B1); PG8_BAR;
            PG8_LDA(At, 1, 1); PG8_STAGE(PG8_SA(1, 0), a3, voffA);
            PG8_BAR; PG8_WAIT_L(0); PG8_MMA(1, 0, At, B0); PG8_BAR; PG8_SCHED;
            PG8_STAGE(PG8_SB(1, 1), b3 + hstep, voffB);
            PG8_WAIT_V(6); PG8_BAR; PG8_MMA(1, 1, At, B1); PG8_BAR;
            }
        }
        if constexpr (ALIGN_EPI) { if (wr == 0) PG8_BAR; }
        if constexpr (!Epi::AFTER_DRAIN) { E(acc, cur, wr, wc, fr, fq); S.done(cur); }
        if (!has_next) break;
#pragma unroll
        for (int a = 0; a < 2; ++a)
#pragma unroll
            for (int b = 0; b < 2; ++b)
#pragma unroll
                for (int m = 0; m < 4; ++m)
#pragma unroll
                    for (int n = 0; n < 2; ++n) acc[a][b][m][n] = (f32x4){0.f, 0.f, 0.f, 0.f};
        cur = nxt; cA = nA; cB = nB; ++ui;
        if constexpr (ALIGN_EPI) { if (wr == 1) PG8_BAR; }
    }
    PG8_WAIT_V(0);
    if constexpr (!ALIGN_EPI) { if (wr == 0) PG8_BAR; }
    PG8_BAR;
    if constexpr (Epi::AFTER_DRAIN) { E.fused(acc, cur, wr, wc, fr, fq, lds, wid, lane); S.done(cur); }
#undef PG8_SA
#undef PG8_SB
#undef PG8_STAGE
#undef PG8_LDA
#undef PG8_LDB
#undef PG8_MMA
#undef PG8_WAIT_V
#undef PG8_WAIT_L
#undef PG8_BAR
#undef PG8_SCHED
}
}
constexpr int D = 2048, BATCH = 2, SEQ = 16384, MTOK = BATCH * SEQ, DFF = 5632, NMOD = 9, DEPTH = 4;
constexpr int NWAVES = 8, NTHREADS = NWAVES * 64;
constexpr int SSM_G = 128, SSM_K = 16, SSM_P = 64, S5_NSEG = 8, S5_LSEG = SEQ / S5_NSEG;
constexpr int GLA_H = 4, GLA_DK = 1024, GLA_DV = 2048, GLA_DKH = 256, GLA_DVH = 512, GLA_RANK = 16, GLA_C = 64, GLA_NPROJ = 6176, GLA_NPAD = 6400, GLA_NCHUNK = SEQ / GLA_C;
constexpr int DSA_G = 3, DSA_H = 8, DSA_HD = 128, DSA_QKV = 9216, DSA_OUT = 1024;
constexpr size_t MiB = (size_t)1 << 20;
constexpr size_t WS_CTL = 0, CTL_ZERO_BYTES = 64 * 1024;
constexpr size_t WS_MOD = 1 * MiB;
constexpr size_t WS_COS = 2 * MiB, WS_SIN = 6 * MiB;
constexpr size_t WS_S5E = 10 * MiB;
constexpr size_t WS_W1I = 16 * MiB, WS_W1O = 60 * MiB, WS_W2I = 82 * MiB, WS_W2O = 126 * MiB, WS_WMI = 148 * MiB, WS_WMO = 184 * MiB;
constexpr size_t WS_H = 200 * MiB;
constexpr size_t WS_B1 = 328 * MiB;
constexpr size_t WS_B2 = 904 * MiB;
constexpr size_t WS_END = 1480 * MiB;
constexpr size_t S5_YF = WS_B2, S5_YB = WS_B2 + 256 * MiB;
constexpr size_t GLA_QD = WS_B2, GLA_KL = WS_B2 + 128 * MiB, GLA_ATT = WS_B2 + 256 * MiB, GLA_DEC = WS_B2 + 288 * MiB, GLA_OD = WS_B2 + 292 * MiB;
constexpr size_t DSA_PO = WS_B2, DSA_LSE = WS_B2 + 384 * MiB;
constexpr int LDS_BYTES = 160 * 1024 - 512;
constexpr int LDS_MISC = LDS_BYTES - 64;

typedef unsigned short bf16_t;
typedef short bf16x8 __attribute__((ext_vector_type(8)));
typedef short bf16x4 __attribute__((ext_vector_type(4)));
typedef float f32x4 __attribute__((ext_vector_type(4)));
typedef float f32x16 __attribute__((ext_vector_type(16)));
typedef unsigned u32x4 __attribute__((ext_vector_type(4)));
typedef unsigned u32x2 __attribute__((ext_vector_type(2)));

__device__ __forceinline__ unsigned pk2(float lo, float hi) { unsigned r; asm volatile("v_cvt_pk_bf16_f32 %0, %1, %2" : "=v"(r) : "v"(lo), "v"(hi)); return r; }
__device__ __forceinline__ float bf_lo(unsigned w) { return __uint_as_float(w << 16); }
__device__ __forceinline__ float bf_hi(unsigned w) { return __uint_as_float(w & 0xffff0000u); }
__device__ __forceinline__ float bf2f(bf16_t b) { return __uint_as_float(((unsigned)b) << 16); }
#define LDS_WAIT() asm volatile("s_waitcnt lgkmcnt(0)" ::: "memory")
#define VM_WAIT() asm volatile("s_waitcnt vmcnt(0)" ::: "memory")

__device__ __forceinline__ void sincos_f(float x, float& s, float& c) {
    const float k = __builtin_rintf(x * 0.636619772367581343f);
    float r = __builtin_fmaf(-k, 1.5707963705062866f, x); r = __builtin_fmaf(-k, -4.371138828673793e-08f, r); r = __builtin_fmaf(-k, -1.7151245100058819e-15f, r);
    const float r2 = r * r;
    float sp = 2.7557319e-6f; sp = __builtin_fmaf(sp, r2, -1.9841270e-4f); sp = __builtin_fmaf(sp, r2, 8.3333333e-3f); sp = __builtin_fmaf(sp, r2, -1.6666667e-1f);
    const float sr = __builtin_fmaf(r * r2, sp, r);
    float cp = -2.7557319e-7f; cp = __builtin_fmaf(cp, r2, 2.4801587e-5f); cp = __builtin_fmaf(cp, r2, -1.3888889e-3f); cp = __builtin_fmaf(cp, r2, 4.1666667e-2f);
    const float cr = __builtin_fmaf(r2 * r2, cp, __builtin_fmaf(-0.5f, r2, 1.0f));
    const int q = ((int)k) & 3;
    s = (q == 0) ? sr : (q == 1) ? cr : (q == 2) ? -sr : -cr;
    c = (q == 0) ? cr : (q == 1) ? -sr : (q == 2) ? -cr : sr;
}

struct Frame {
    LAS unsigned char* lds;
    int tid, lane, wave, G, bid;
};

__device__ __forceinline__ float shx(float v, int o, int lane) { return __int_as_float(__builtin_amdgcn_ds_bpermute((lane ^ o) << 2, __float_as_int(v))); }
__device__ __forceinline__ float wave_sum(float v, int lane) {
#pragma unroll
    for (int o = 1; o < 64; o <<= 1) v += shx(v, o, lane);
    return v;
}
template <int MODE>
__device__ __forceinline__ void transpose_item(const float* __restrict__ W, int K, int N, bf16_t* __restrict__ WT, int NH, LAS float* scr, int item, int lane) {
    const int nblk = N / 32, kb = item / nblk, nb = item % nblk, k0 = 64 * kb, n0 = 32 * nb;
    int d0 = n0;
    if (MODE == 1) { const int bj = n0 / NH, jj = n0 % NH; d0 = 256 * (jj / 128) + 128 * bj + (jj % 128); }
#pragma unroll 8
    for (int i = 0; i < 32; ++i) { const int kk = 2 * i + (lane >> 5); scr[kk * 33 + (lane & 31)] = W[(size_t)(k0 + kk) * N + n0 + (lane & 31)]; }
    LDS_WAIT(); asm volatile("" ::: "memory");
    const int c = lane & 7;
#pragma unroll
    for (int j = 0; j < 4; ++j) { const int n = (lane >> 3) + 8 * j; const LAS float* s = scr + (8 * c) * 33 + n;
        u32x4 o; o.x = pk2(s[0 * 33], s[1 * 33]); o.y = pk2(s[2 * 33], s[3 * 33]); o.z = pk2(s[4 * 33], s[5 * 33]); o.w = pk2(s[6 * 33], s[7 * 33]);
        *(u32x4*)(WT + (size_t)(d0 + n) * K + k0 + 8 * c) = o; }
    LDS_WAIT(); asm volatile("" ::: "memory");
}
template <int MODE>
__device__ __forceinline__ void convert_matrix(const Frame& F, const float* W, int K, int N, bf16_t* WT, int NH) {
    LAS float* scr = (LAS float*)(F.lds + F.wave * 16384);
    const int gw = F.bid * NWAVES + F.wave, NGW = F.G * NWAVES, nitems = (K / 64) * (N / 32);
    for (int it = gw; it < nitems; it += NGW) transpose_item<MODE>(W, K, N, WT, NH, scr, it, F.lane);
}
__device__ __forceinline__ void zero_bf16(const Frame& F, bf16_t* p, size_t n8) {
    unsigned zz = 0u; asm volatile("" : "+v"(zz)); const u32x4 z = {zz, zz, zz, zz};
    for (size_t i = (size_t)F.bid * NTHREADS + F.tid; i < n8; i += (size_t)F.G * NTHREADS) ((u32x4*)p)[i] = z;
}
__device__ __forceinline__ void mod_phase(const Frame& F, const float* __restrict__ c, const float* __restrict__ ada_w, const float* __restrict__ ada_b, float* __restrict__ mod) {
    constexpr int NCOL = NMOD * D, UPL = NCOL / 256, NUNIT = DEPTH * UPL;
    LAS float* red = (LAS float*)F.lds;
    for (int u = F.bid; u < NUNIT; u += F.G) {
        const int layer = u / UPL, n0 = (u % UPL) * 256 + 4 * F.lane;
        const float* Wp = ada_w + (size_t)layer * D * NCOL + n0;
        f32x4 a0 = {0.f, 0.f, 0.f, 0.f}, a1 = {0.f, 0.f, 0.f, 0.f};
        const int kbeg = F.wave * 256;
#pragma unroll 4
        for (int k = kbeg; k < kbeg + 256; ++k) {
            const f32x4 w = *(const f32x4*)(Wp + (size_t)k * NCOL);
            const float c0 = c[k], c1 = c[D + k];
            const float s0 = c0 / (1.0f + __expf(-c0)), s1 = c1 / (1.0f + __expf(-c1));
            a0 += w * s0; a1 += w * s1;
        }
        __syncthreads();
        *(LAS f32x4*)(red + (F.wave * 2 + 0) * 256 + 4 * F.lane) = a0;
        *(LAS f32x4*)(red + (F.wave * 2 + 1) * 256 + 4 * F.lane) = a1;
        __syncthreads();
        { const int b = F.tid >> 8, col = F.tid & 255; float s = 0.f;
#pragma unroll
          for (int w = 0; w < 8; ++w) s += red[(w * 2 + b) * 256 + col];
          const int n = (u % UPL) * 256 + col;
          mod[((size_t)layer * BATCH + b) * NCOL + n] = s + ada_b[(size_t)layer * NCOL + n]; }
    }
    __syncthreads();
}
__device__ __forceinline__ void rope_phase(const Frame& F, const float* __restrict__ invf, float* __restrict__ cs, float* __restrict__ sn) {
    for (int i = F.bid * NTHREADS + F.tid; i < SEQ * 64; i += F.G * NTHREADS) {
        const int pos = i >> 6, j = i & 63;
        const float ang = (float)pos * invf[j];
        float s, c; sincos_f(ang, s, c);
        cs[i] = c; sn[i] = s;
    }
}
__device__ __forceinline__ void norm_phase(const Frame& F, const float* __restrict__ X, const float* __restrict__ g, const float* __restrict__ shift, const float* __restrict__ scale, int bstride, bf16_t* __restrict__ H) {
    const int gw = F.bid * NWAVES + F.wave, NGW = F.G * NWAVES;
    for (int r0 = gw * 16; r0 < MTOK; r0 += NGW * 16) {
        const int b = r0 / SEQ;
        f32x4 A[8], B[8];
#pragma unroll
        for (int j = 0; j < 8; ++j) { const int c = 4 * F.lane + 256 * j; const f32x4 gg = *(const f32x4*)(g + c), sc = *(const f32x4*)(scale + (size_t)b * bstride + c);
            A[j] = gg * (sc + 1.0f); B[j] = *(const f32x4*)(shift + (size_t)b * bstride + c); }
        for (int r = r0; r < r0 + 16; ++r) {
            const f32x4* xr = (const f32x4*)(X + (size_t)r * D) + F.lane;
            f32x4 v[8]; float s = 0.f;
#pragma unroll
            for (int j = 0; j < 8; ++j) { v[j] = xr[64 * j]; s += (v[j].x * v[j].x + v[j].y * v[j].y) + (v[j].z * v[j].z + v[j].w * v[j].w); }
            const float rstd = 1.0f / sqrtf(wave_sum(s, F.lane) * (1.0f / D) + 1e-6f);
            unsigned long long* o8 = (unsigned long long*)(H + (size_t)r * D) + F.lane;
#pragma unroll
            for (int j = 0; j < 8; ++j) { const f32x4 y = v[j] * rstd * A[j] + B[j];
                o8[64 * j] = (unsigned long long)pk2(y.x, y.y) | ((unsigned long long)pk2(y.z, y.w) << 32); }
        }
    }
}
template <int PASS>
__device__ __forceinline__ void s5_scan(const Frame& F, int jl, const bf16_t* __restrict__ U, const float* __restrict__ lam_re, const float* __restrict__ lam_im, const float* __restrict__ log_dt,
                                        const float* __restrict__ b_re, const float* __restrict__ b_im, const float* __restrict__ c_re, const float* __restrict__ c_im,
                                        float* __restrict__ E, float* __restrict__ YF, float* __restrict__ YB) {
    const int lane = F.lane, c = lane & 31, h = lane >> 5, i15 = lane & 15, kq = lane >> 4;
    const int gw = F.bid * NWAVES + F.wave, NGW = F.G * NWAVES;
    constexpr int NS = (PASS == 1) ? S5_NSEG - 1 : S5_NSEG;
    constexpr int NIT = SSM_G * 2 * NS;
    constexpr int TP = 272;
    LAS unsigned char* tile = F.lds + F.wave * (32 * TP);
    for (int it = gw; it < NIT; it += NGW) {
        const int seg = it % NS, dir = (it / NS) & 1, g = it / (NS * 2);
        const int pb = (jl * 2 + dir) * SSM_G + g;
        const float dt = expf(log_dt[pb]);
        float ar[2], ai[2], Lr[2], Li[2], fr[2], fi[2];
#pragma unroll
        for (int s = 0; s < 2; ++s) {
            const int p = 2 * c + s;
            const float lr = lam_re[pb * SSM_P + p], li = lam_im[pb * SSM_P + p], zr = lr * dt, zi = li * dt;
            const float em1 = expm1f(zr), mag = em1 + 1.0f; float sn, cs, sh, ch; sincos_f(zi, sn, cs); sincos_f(0.5f * zi, sh, ch);
            const float a_r = mag * cs, a_i = mag * sn, am1 = em1 * cs - 2.0f * sh * sh, den = lr * lr + li * li;
            fr[s] = (am1 * lr + a_i * li) / den; fi[s] = (a_i * lr - am1 * li) / den;
            ar[s] = a_r; ai[s] = a_i;
            const float magL = expf(zr * (float)S5_LSEG); sincos_f(zi * (float)S5_LSEG, sn, cs);
            Lr[s] = magL * cs; Li[s] = magL * sn;
        }
        bf16x8 Bf[4];
#pragma unroll
        for (int s = 0; s < 2; ++s) {
            const int p = 2 * c + s;
            const float* pr = b_re + ((size_t)pb * SSM_P + p) * SSM_K + 8 * h; const float* pi = b_im + ((size_t)pb * SSM_P + p) * SSM_K + 8 * h;
            const f32x4 r0 = *(const f32x4*)pr, r1 = *(const f32x4*)(pr + 4), i0 = *(const f32x4*)pi, i1 = *(const f32x4*)(pi + 4);
            float vr[8], vi[8];
#pragma unroll
            for (int j = 0; j < 4; ++j) { vr[j] = fr[s] * r0[j] - fi[s] * i0[j]; vr[4 + j] = fr[s] * r1[j] - fi[s] * i1[j];
                                          vi[j] = fr[s] * i0[j] + fi[s] * r0[j]; vi[4 + j] = fr[s] * i1[j] + fi[s] * r1[j]; }
            u32x4 wr_, wi_; wr_.x = pk2(vr[0], vr[1]); wr_.y = pk2(vr[2], vr[3]); wr_.z = pk2(vr[4], vr[5]); wr_.w = pk2(vr[6], vr[7]);
            wi_.x = pk2(vi[0], vi[1]); wi_.y = pk2(vi[2], vi[3]); wi_.z = pk2(vi[4], vi[5]); wi_.w = pk2(vi[6], vi[7]);
            Bf[s] = __builtin_bit_cast(bf16x8, wr_); Bf[2 + s] = __builtin_bit_cast(bf16x8, wi_);
        }
        bf16x8 Cf[4];
        if (PASS == 2) {
#pragma unroll
            for (int ks = 0; ks < 4; ++ks) {
                const float* src = ((ks >> 1) ? c_im : c_re) + ((size_t)pb * SSM_K + i15) * SSM_P + 32 * (ks & 1) + 8 * kq;
                const float sg = (ks >> 1) ? -1.0f : 1.0f;
                const f32x4 v0 = *(const f32x4*)src * sg, v1 = *(const f32x4*)(src + 4) * sg;
                u32x4 w; w.x = pk2(v0[0], v0[1]); w.y = pk2(v0[2], v0[3]); w.z = pk2(v1[0], v1[1]); w.w = pk2(v1[2], v1[3]);
                Cf[ks] = __builtin_bit_cast(bf16x8, w);
            }
        }
        float sr[2] = {0.f, 0.f}, si[2] = {0.f, 0.f};
        if (PASS == 2) {
            for (int i = 0; i < seg; ++i) {
                const f32x4 e = *(const f32x4*)(E + ((((size_t)(dir * SSM_G + g) * S5_NSEG + i) * 2 + h) * SSM_P + 2 * c) * 2);
                const float n0r = Lr[0] * sr[0] - Li[0] * si[0] + e[0], n0i = Lr[0] * si[0] + Li[0] * sr[0] + e[1];
                const float n1r = Lr[1] * sr[1] - Li[1] * si[1] + e[2], n1i = Lr[1] * si[1] + Li[1] * sr[1] + e[3];
                sr[0] = n0r; si[0] = n0i; sr[1] = n1r; si[1] = n1i;
            }
        }
        const int rr = lane & 31, hrow = (rr >> 2) & 1, tau_a = 4 * (rr >> 3) + (rr & 3);
        const bf16_t* Ucol = U + (size_t)hrow * SEQ * D + 16 * g + 8 * h;
        const int nbase = seg * S5_LSEG;
        float* Y = dir ? YB : YF;
#define S5_TPOS(n) (dir ? (SEQ - 1 - (n)) : (n))
        bf16x8 Acur = *(const bf16x8*)(Ucol + (size_t)S5_TPOS(nbase + tau_a) * D);
        for (int w = 0; w < S5_LSEG / 16; ++w) {
            const int wn = (w + 1 < S5_LSEG / 16) ? w + 1 : w;
            const bf16x8 Anext = *(const bf16x8*)(Ucol + (size_t)S5_TPOS(nbase + 16 * wn + tau_a) * D);
            f32x16 acc[4];
#pragma unroll
            for (int nb = 0; nb < 4; ++nb) { f32x16 z;
#pragma unroll
                for (int q = 0; q < 16; ++q) z[q] = 0.f;
                acc[nb] = __builtin_amdgcn_mfma_f32_32x32x16_bf16(Acur, Bf[nb], z, 0, 0, 0); }
#pragma unroll
            for (int tau = 0; tau < 16; ++tau) {
                const float n0r = ar[0] * sr[0] - ai[0] * si[0] + acc[0][tau], n0i = ar[0] * si[0] + ai[0] * sr[0] + acc[2][tau];
                const float n1r = ar[1] * sr[1] - ai[1] * si[1] + acc[1][tau], n1i = ar[1] * si[1] + ai[1] * sr[1] + acc[3][tau];
                sr[0] = n0r; si[0] = n0i; sr[1] = n1r; si[1] = n1i;
                if (PASS == 2) {
                    *(LAS unsigned*)(tile + (16 * h + tau) * TP + 4 * c) = pk2(n0r, n1r);
                    *(LAS unsigned*)(tile + (16 * h + tau) * TP + 128 + 4 * c) = pk2(n0i, n1i);
                }
            }
            if (PASS == 2) {
                LDS_WAIT();
#pragma unroll
                for (int mb = 0; mb < 2; ++mb) {
                    f32x4 y = {0.f, 0.f, 0.f, 0.f};
#pragma unroll
                    for (int ks = 0; ks < 4; ++ks) { const bf16x8 Af = *(const LAS bf16x8*)(tile + (16 * mb + i15) * TP + (32 * ks + 8 * kq) * 2);
                        y = __builtin_amdgcn_mfma_f32_16x16x32_bf16(Af, Cf[ks], y, 0, 0, 0); }
#pragma unroll
                    for (int e = 0; e < 4; ++e) { const int t = S5_TPOS(nbase + 16 * w + 4 * kq + e);
                        Y[((size_t)mb * SEQ + t) * D + 16 * g + i15] = y[e]; }
                }
            }
            Acur = Anext;
        }
        if (PASS == 1) {
            f32x4 e = {sr[0], si[0], sr[1], si[1]};
            *(f32x4*)(E + ((((size_t)(dir * SSM_G + g) * S5_NSEG + seg) * 2 + h) * SSM_P + 2 * c) * 2) = e;
        }
    }
}
#undef S5_TPOS
__device__ __forceinline__ void s5_post(const Frame& F, const float* __restrict__ YF, const float* __restrict__ YB, const bf16_t* __restrict__ U, const float* __restrict__ dv, bf16_t* __restrict__ O) {
    const size_t n8 = (size_t)MTOK * D / 8;
    for (size_t i = (size_t)F.bid * NTHREADS + F.tid; i < n8; i += (size_t)F.G * NTHREADS) {
        const int col = (int)(i % (D / 8)) * 8;
        const f32x4 a0 = *(const f32x4*)(YF + i * 8), a1 = *(const f32x4*)(YF + i * 8 + 4), b0 = *(const f32x4*)(YB + i * 8), b1 = *(const f32x4*)(YB + i * 8 + 4);
        const f32x4 d0 = *(const f32x4*)(dv + col), d1 = *(const f32x4*)(dv + col + 4);
        const u32x4 uw = *(const u32x4*)(U + i * 8);
        float y[8];
        y[0] = a0[0] + b0[0] + d0[0] * bf_lo(uw.x); y[1] = a0[1] + b0[1] + d0[1] * bf_hi(uw.x); y[2] = a0[2] + b0[2] + d0[2] * bf_lo(uw.y); y[3] = a0[3] + b0[3] + d0[3] * bf_hi(uw.y);
        y[4] = a1[0] + b1[0] + d1[0] * bf_lo(uw.z); y[5] = a1[1] + b1[1] + d1[1] * bf_hi(uw.z); y[6] = a1[2] + b1[2] + d1[2] * bf_lo(uw.w); y[7] = a1[3] + b1[3] + d1[3] * bf_hi(uw.w);
#pragma unroll
        for (int j = 0; j < 8; ++j) { const float z = 0.7978845608028654f * (y[j] + 0.044715f * y[j] * y[j] * y[j]); y[j] = y[j] * __builtin_amdgcn_rcpf(1.0f + __expf(-2.0f * z)); }
        u32x4 o; o.x = pk2(y[0], y[1]); o.y = pk2(y[2], y[3]); o.z = pk2(y[4], y[5]); o.w = pk2(y[6], y[7]);
        *(u32x4*)(O + i * 8) = o;
    }
}
__device__ __forceinline__ bf16x8 tr_read2(unsigned a0, unsigned a1) {
    bf16x4 r0, r1;
    asm volatile("ds_read_b64_tr_b16 %0, %2\n\tds_read_b64_tr_b16 %1, %3\n\ts_waitcnt lgkmcnt(0)" : "=&v"(r0), "=&v"(r1) : "v"(a0), "v"(a1) : "memory");
    bf16x8 o; o[0] = r0[0]; o[1] = r0[1]; o[2] = r0[2]; o[3] = r0[3]; o[4] = r1[0]; o[5] = r1[1]; o[6] = r1[2]; o[7] = r1[3]; return o;
}
__device__ __forceinline__ unsigned lds_addr(const LAS unsigned char* p) { return (unsigned)(unsigned long long)p; }
constexpr int GLA_QP = 528;
constexpr int GLA_AP = 144;
constexpr int GLA_VP = 272;

__device__ __forceinline__ void gla_a(const Frame& F, int jb, const bf16_t* __restrict__ PROJ, const float* __restrict__ w_gate, const float* __restrict__ b_gate,
                                      bf16_t* __restrict__ QD, bf16_t* __restrict__ KL, bf16_t* __restrict__ ATT, float* __restrict__ DEC) {
    LAS float* Gt = (LAS float*)F.lds;
    LAS float* Tt = (LAS float*)(F.lds + 4096);
    LAS unsigned char* QDt = F.lds + 8192;
    LAS unsigned char* KDt = F.lds + 8192 + 64 * GLA_QP;
    const int tid = F.tid, lane = F.lane, w = F.wave, i15 = lane & 15, kq = lane >> 4;
    const int kk = tid & 255, half = tid >> 8;
    for (int item = F.bid; item < 16 * GLA_NCHUNK; item += F.G) {
        const int c = item & (GLA_NCHUNK - 1), seq = item >> 8, dir = seq & 1, hh = (seq >> 1) & 3, b = seq >> 3;
        const int n0 = GLA_C * c;
        __syncthreads();
        if (tid < 128) { const int n = tid >> 1, h8 = tid & 1, nn = n0 + n, t = dir ? (SEQ - 1 - nn) : nn;
            const u32x4 wv = *(const u32x4*)(PROJ + (size_t)(b * SEQ + t) * GLA_NPAD + 6144 + 16 * dir + 8 * h8);
            LAS float* gp = Gt + n * 16 + 8 * h8;
            gp[0] = bf_lo(wv.x); gp[1] = bf_hi(wv.x); gp[2] = bf_lo(wv.y); gp[3] = bf_hi(wv.y); gp[4] = bf_lo(wv.z); gp[5] = bf_hi(wv.z); gp[6] = bf_lo(wv.w); gp[7] = bf_hi(wv.w); }
        float wg[16];
#pragma unroll
        for (int r = 0; r < 16; ++r) wg[r] = w_gate[((size_t)(jb * 2 + dir) * GLA_RANK + r) * GLA_DK + GLA_DKH * hh + kk];
        const float bias = b_gate[(size_t)(jb * 2 + dir) * GLA_DK + GLA_DKH * hh + kk];
        __syncthreads();
        float bc[32]; float run = 0.f;
#pragma unroll
        for (int i = 0; i < 32; ++i) { const LAS f32x4* gr = (const LAS f32x4*)(Gt + (32 * half + i) * 16);
            const f32x4 g0 = gr[0], g1 = gr[1], g2 = gr[2], g3 = gr[3];
            float gl = bias;
#pragma unroll
            for (int r = 0; r < 4; ++r) gl += g0[r] * wg[r] + g1[r] * wg[4 + r] + g2[r] * wg[8 + r] + g3[r] * wg[12 + r];
            const float ls = fminf(gl, 0.f) - __logf(1.0f + __expf(-fabsf(gl)));
            run += ls * (1.0f / 16.0f); bc[i] = run; }
        Tt[half * 256 + kk] = run;
        __syncthreads();
        const float t0 = Tt[kk], blast = t0 + Tt[256 + kk];
        if (half) {
#pragma unroll
            for (int i = 0; i < 32; ++i) bc[i] += t0; }
        const size_t grow = (size_t)seq * SEQ + n0;
#pragma unroll
        for (int i = 0; i < 32; ++i) { const int n = 32 * half + i, nn = n0 + n, t = dir ? (SEQ - 1 - nn) : nn;
            const bf16_t* rowp = PROJ + (size_t)(b * SEQ + t) * GLA_NPAD + GLA_DKH * hh + kk;
            const float q = bf2f(rowp[0]), k = bf2f(rowp[GLA_DK]);
            const float qd = q * 0.0625f * __expf(bc[i]), kd = k * __expf(-bc[i]), kl = k * __expf(blast - bc[i]);
            const unsigned pq = pk2(qd, kd), pl = pk2(kl, 0.f);
            *(LAS bf16_t*)(QDt + n * GLA_QP + kk * 2) = (bf16_t)(pq & 0xffffu); *(LAS bf16_t*)(KDt + n * GLA_QP + kk * 2) = (bf16_t)(pq >> 16);
            QD[(grow + n) * GLA_DKH + kk] = (bf16_t)(pq & 0xffffu); KL[(grow + n) * GLA_DKH + kk] = (bf16_t)(pl & 0xffffu); }
        if (half == 0) DEC[((size_t)seq * GLA_NCHUNK + c) * GLA_DKH + kk] = __expf(blast);
        __syncthreads();
        const int sb = w >> 1;
        f32x4 acc[2] = {{0.f, 0.f, 0.f, 0.f}, {0.f, 0.f, 0.f, 0.f}};
#pragma unroll
        for (int ks = 0; ks < 8; ++ks) { const bf16x8 Af = *(const LAS bf16x8*)(KDt + (16 * sb + i15) * GLA_QP + (32 * ks + 8 * kq) * 2);
#pragma unroll
            for (int j = 0; j < 2; ++j) { const int nb = 2 * (w & 1) + j; const bf16x8 Bq = *(const LAS bf16x8*)(QDt + (16 * nb + i15) * GLA_QP + (32 * ks + 8 * kq) * 2);
                acc[j] = __builtin_amdgcn_mfma_f32_16x16x32_bf16(Af, Bq, acc[j], 0, 0, 0); } }
#pragma unroll
        for (int j = 0; j < 2; ++j) { const int n = 16 * (2 * (w & 1) + j) + i15, s0 = 16 * sb + 4 * kq;
            float v[4];
#pragma unroll
            for (int e = 0; e < 4; ++e) { const int s = s0 + e; const bool keep = dir ? (s < n) : (s <= n); v[e] = keep ? acc[j][e] : 0.f; }
            u32x2 o; o.x = pk2(v[0], v[1]); o.y = pk2(v[2], v[3]);
            *(u32x2*)(ATT + ((size_t)item * GLA_C + n) * GLA_C + s0) = o; }
    }
    __syncthreads();
}

__device__ __forceinline__ void gla_b(const Frame& F, const bf16_t* __restrict__ PROJ, const bf16_t* __restrict__ QD, const bf16_t* __restrict__ KL, const bf16_t* __restrict__ ATT,
                                      const float* __restrict__ DEC, bf16_t* __restrict__ OD) {
    if (F.bid >= 64) return;
    LAS unsigned char* QDt = F.lds;
    LAS unsigned char* KLt = F.lds + 64 * GLA_QP;
    LAS unsigned char* ATt = F.lds + 128 * GLA_QP;
    LAS unsigned char* Vt = ATt + 64 * GLA_AP;
    LAS unsigned char* DCt = Vt + 64 * GLA_VP;
    const int tid = F.tid, lane = F.lane, w = F.wave, i15 = lane & 15, kq = lane >> 4, qq = (lane & 15) >> 2, p = lane & 3;
    const int qv = F.bid & 3, seq = F.bid >> 2, dir = seq & 1, hh = (seq >> 1) & 3, b = seq >> 3;
    f32x4 S[16];
#pragma unroll
    for (int i = 0; i < 16; ++i) S[i] = (f32x4){0.f, 0.f, 0.f, 0.f};
    u32x4 rq[4], rk[4], ra, rv[2]; f32x4 rd = {0.f, 0.f, 0.f, 0.f};
#define GLA_B_LOAD(cc) do { \
        const u32x4* qsrc = (const u32x4*)(QD + ((size_t)seq * SEQ + (size_t)GLA_C * (cc)) * GLA_DKH); const u32x4* ksrc = (const u32x4*)(KL + ((size_t)seq * SEQ + (size_t)GLA_C * (cc)) * GLA_DKH); \
        _Pragma("unroll") for (int i = 0; i < 4; ++i) { rq[i] = qsrc[tid + 512 * i]; rk[i] = ksrc[tid + 512 * i]; } \
        ra = ((const u32x4*)(ATT + ((size_t)seq * GLA_NCHUNK + (cc)) * (GLA_C * GLA_C)))[tid]; \
        _Pragma("unroll") for (int i = 0; i < 2; ++i) { const int q_ = tid + 512 * i, n_ = q_ >> 4, ch_ = q_ & 15, nn_ = GLA_C * (cc) + n_, t_ = dir ? (SEQ - 1 - nn_) : nn_; \
            rv[i] = *(const u32x4*)(PROJ + (size_t)(b * SEQ + t_) * GLA_NPAD + 2048 + GLA_DVH * hh + 128 * qv + 8 * ch_); } \
        if (tid < 64) rd = *(const f32x4*)(DEC + ((size_t)seq * GLA_NCHUNK + (cc)) * GLA_DKH + 4 * tid); } while (0)
    GLA_B_LOAD(0);
    for (int c = 0; c < GLA_NCHUNK; ++c) {
        __syncthreads();
#pragma unroll
        for (int i = 0; i < 4; ++i) { const int q_ = tid + 512 * i, row = q_ >> 5, ch = q_ & 31;
            *(LAS u32x4*)(QDt + row * GLA_QP + ch * 16) = rq[i]; *(LAS u32x4*)(KLt + row * GLA_QP + ch * 16) = rk[i]; }
        *(LAS u32x4*)(ATt + (tid >> 3) * GLA_AP + (tid & 7) * 16) = ra;
#pragma unroll
        for (int i = 0; i < 2; ++i) { const int q_ = tid + 512 * i; *(LAS u32x4*)(Vt + (q_ >> 4) * GLA_VP + (q_ & 15) * 16) = rv[i]; }
        if (tid < 64) *(LAS f32x4*)(DCt + 16 * tid) = rd;
        __syncthreads();
        if (c + 1 < GLA_NCHUNK) GLA_B_LOAD(c + 1);
        unsigned vtb = lds_addr(Vt + (8 * kq + qq) * GLA_VP + (16 * w + 4 * p) * 2), klb = lds_addr(KLt + (8 * kq + qq) * GLA_QP + (4 * p) * 2);
        asm volatile("" : "+v"(vtb), "+v"(klb));
        bf16x8 Vf[2];
#pragma unroll
        for (int ks = 0; ks < 2; ++ks) { const unsigned a0 = vtb + (32 * ks) * GLA_VP; Vf[ks] = tr_read2(a0, a0 + 4 * GLA_VP); }
        f32x4 o[4];
#pragma unroll
        for (int rb = 0; rb < 4; ++rb) { o[rb] = (f32x4){0.f, 0.f, 0.f, 0.f};
#pragma unroll
            for (int ks = 0; ks < 2; ++ks) { const bf16x8 Af = *(const LAS bf16x8*)(ATt + (16 * rb + i15) * GLA_AP + (32 * ks + 8 * kq) * 2);
                o[rb] = __builtin_amdgcn_mfma_f32_16x16x32_bf16(Af, Vf[ks], o[rb], 0, 0, 0); } }
#pragma unroll
        for (int kb2 = 0; kb2 < 8; ++kb2) {
            u32x4 bw; bw.x = pk2(S[2 * kb2][0], S[2 * kb2][1]); bw.y = pk2(S[2 * kb2][2], S[2 * kb2][3]); bw.z = pk2(S[2 * kb2 + 1][0], S[2 * kb2 + 1][1]); bw.w = pk2(S[2 * kb2 + 1][2], S[2 * kb2 + 1][3]);
            const bf16x8 Bs = __builtin_bit_cast(bf16x8, bw);
#pragma unroll
            for (int rb = 0; rb < 4; ++rb) { const LAS unsigned char* ap = QDt + (16 * rb + i15) * GLA_QP + (32 * kb2 + 4 * kq) * 2;
                const u32x2 lo = *(const LAS u32x2*)ap, hi = *(const LAS u32x2*)(ap + 32);
                u32x4 aw; aw.x = lo.x; aw.y = lo.y; aw.z = hi.x; aw.w = hi.y;
                o[rb] = __builtin_amdgcn_mfma_f32_16x16x32_bf16(__builtin_bit_cast(bf16x8, aw), Bs, o[rb], 0, 0, 0); } }
#pragma unroll
        for (int rb = 0; rb < 4; ++rb)
#pragma unroll
            for (int e = 0; e < 4; ++e) { const int nn = GLA_C * c + 16 * rb + 4 * kq + e, t = dir ? (SEQ - 1 - nn) : nn;
                OD[((size_t)dir * MTOK + (size_t)b * SEQ + t) * GLA_DV + GLA_DVH * hh + 128 * qv + 16 * w + i15] = (bf16_t)(pk2(o[rb][e], 0.f) & 0xffffu); }
#pragma unroll
        for (int kb = 0; kb < 16; ++kb) {
            const f32x4 d4 = *(const LAS f32x4*)(DCt + (16 * kb + 4 * kq) * 4);
            S[kb] = S[kb] * d4;
#pragma unroll
            for (int ks = 0; ks < 2; ++ks) { const unsigned a0 = klb + (32 * ks) * GLA_QP + (16 * kb) * 2;
                S[kb] = __builtin_amdgcn_mfma_f32_16x16x32_bf16(tr_read2(a0, a0 + 4 * GLA_QP), Vf[ks], S[kb], 0, 0, 0); } }
    }
#undef GLA_B_LOAD
}

__device__ __forceinline__ void gla_c(const Frame& F, const bf16_t* __restrict__ PROJ, const bf16_t* __restrict__ OD, const float* __restrict__ ng, bf16_t* __restrict__ O) {
    const int gw = F.bid * NWAVES + F.wave, NGW = F.G * NWAVES, lane = F.lane;
    for (int row = gw; row < MTOK; row += NGW) {
        const u32x4* pf = (const u32x4*)(OD + (size_t)row * GLA_DV + 32 * lane); const u32x4* pb = (const u32x4*)(OD + ((size_t)MTOK + row) * GLA_DV + 32 * lane);
        const u32x4* pr = (const u32x4*)(PROJ + (size_t)row * GLA_NPAD + 4096 + 32 * lane);
        float v[32]; float ss = 0.f;
#pragma unroll
        for (int j = 0; j < 4; ++j) { const u32x4 a = pf[j], bq = pb[j];
            v[8 * j + 0] = bf_lo(a.x) + bf_lo(bq.x); v[8 * j + 1] = bf_hi(a.x) + bf_hi(bq.x); v[8 * j + 2] = bf_lo(a.y) + bf_lo(bq.y); v[8 * j + 3] = bf_hi(a.y) + bf_hi(bq.y);
            v[8 * j + 4] = bf_lo(a.z) + bf_lo(bq.z); v[8 * j + 5] = bf_hi(a.z) + bf_hi(bq.z); v[8 * j + 6] = bf_lo(a.w) + bf_lo(bq.w); v[8 * j + 7] = bf_hi(a.w) + bf_hi(bq.w); }
#pragma unroll
        for (int j = 0; j < 32; ++j) ss += v[j] * v[j];
        ss += shx(ss, 1, lane); ss += shx(ss, 2, lane); ss += shx(ss, 4, lane); ss += shx(ss, 8, lane);
        const float rstd = 1.0f / sqrtf(ss * (1.0f / GLA_DVH) + 1e-6f);
        u32x4* po = (u32x4*)(O + (size_t)row * GLA_DV + 32 * lane);
#pragma unroll
        for (int j = 0; j < 4; ++j) { const u32x4 rw = pr[j]; const f32x4 g0 = *(const f32x4*)(ng + 32 * lane + 8 * j), g1 = *(const f32x4*)(ng + 32 * lane + 8 * j + 4);
            float r[8] = {bf_lo(rw.x), bf_hi(rw.x), bf_lo(rw.y), bf_hi(rw.y), bf_lo(rw.z), bf_hi(rw.z), bf_lo(rw.w), bf_hi(rw.w)};
            float y[8];
#pragma unroll
            for (int e = 0; e < 8; ++e) { const float gg = e < 4 ? g0[e] : g1[e - 4]; y[e] = v[8 * j + e] * rstd * gg * (r[e] * __builtin_amdgcn_rcpf(1.0f + __expf(-r[e]))); }
            u32x4 ow; ow.x = pk2(y[0], y[1]); ow.y = pk2(y[2], y[3]); ow.z = pk2(y[4], y[5]); ow.w = pk2(y[6], y[7]); po[j] = ow; }
    }
}
__device__ __forceinline__ void dsa_norm(const Frame& F, bf16_t* __restrict__ QKV, const float* __restrict__ qn, const float* __restrict__ kn, const float* __restrict__ COS, const float* __restrict__ SIN) {
    const int gw = F.bid * NWAVES + F.wave, NGW = F.G * NWAVES, lane = F.lane, i = lane & 31;
    for (int row = gw; row < MTOK; row += NGW) {
        const int pos = row & (SEQ - 1);
        const float c0 = COS[pos * 64 + 2 * i], c1 = COS[pos * 64 + 2 * i + 1], s0 = SIN[pos * 64 + 2 * i], s1 = SIN[pos * 64 + 2 * i + 1];
        bf16_t* rp = QKV + (size_t)row * DSA_QKV;
#pragma unroll 4
        for (int it = 0; it < 24; ++it) {
            const int hv = 2 * it + (lane >> 5);
            bf16_t* base = rp + hv * DSA_HD;
            const int g = (hv % 24) >> 3;
            const float* gn = (hv < 24 ? qn : kn) + g * DSA_HD;
            const unsigned w1 = *(const unsigned*)(base + 2 * i), w2 = *(const unsigned*)(base + 64 + 2 * i);
            const float x1a = bf_lo(w1), x1b = bf_hi(w1), x2a = bf_lo(w2), x2b = bf_hi(w2);
            float ss = (x1a * x1a + x1b * x1b) + (x2a * x2a + x2b * x2b);
            ss += shx(ss, 1, lane); ss += shx(ss, 2, lane); ss += shx(ss, 4, lane); ss += shx(ss, 8, lane); ss += shx(ss, 16, lane);
            float rstd = 1.0f / sqrtf(ss * (1.0f / DSA_HD) + 1e-6f);
            const float y1a = x1a * rstd * gn[2 * i], y1b = x1b * rstd * gn[2 * i + 1], y2a = x2a * rstd * gn[64 + 2 * i], y2b = x2b * rstd * gn[64 + 2 * i + 1];
            const float sc = hv < 24 ? 0.08838834764831845f : 1.0f;
            const float o1a = (y1a * c0 - y2a * s0) * sc, o1b = (y1b * c1 - y2b * s1) * sc, o2a = (y2a * c0 + y1a * s0) * sc, o2b = (y2b * c1 + y1b * s1) * sc;
            *(unsigned*)(base + 2 * i) = pk2(o1a, o1b); *(unsigned*)(base + 64 + 2 * i) = pk2(o2a, o2b);
        }
    }
}
constexpr int DSA_TP = 272, DSA_TROWS = 272;
__device__ __forceinline__ void dsa_attn(const Frame& F, const bf16_t* __restrict__ QKV, float* __restrict__ PO, float* __restrict__ LSE) {
    LAS unsigned char* Kt = F.lds;
    LAS unsigned char* Vt = F.lds + DSA_TROWS * DSA_TP;
    const int tid = F.tid, lane = F.lane, w = F.wave, i15 = lane & 15, kq = lane >> 4, qq = (lane & 15) >> 2, p = lane & 3;
    if (tid < 272) { const u32x4 z = {0u, 0u, 0u, 0u}; *(LAS u32x4*)(Kt + 256 * DSA_TP + 16 * tid) = z; *(LAS u32x4*)(Vt + 256 * DSA_TP + 16 * tid) = z; }
    for (int item = F.bid; item < BATCH * DSA_G * DSA_H * 128; item += F.G) {
        const int qbr = item & 127, hd = (item >> 7) & 7, g = (item >> 10) % 3, b = item / 3072;
        const int dil = (g == 0) ? 1 : (g == 1) ? 4 : 16, Ls = SEQ / dil, nqb = Ls / 128, r = qbr / nqb, qb = qbr % nqb;
        const int i0 = 128 * qb - 64;
        const int qcol = (g * 8 + hd) * DSA_HD;
        const bf16_t* Bb = QKV + (size_t)b * SEQ * DSA_QKV;
        const int qi = 128 * qb + 16 * w + i15, qpos = r + dil * qi;
        bf16x8 Qf[4];
#pragma unroll
        for (int ks = 0; ks < 4; ++ks) Qf[ks] = *(const bf16x8*)(Bb + (size_t)qpos * DSA_QKV + qcol + 32 * ks + 8 * kq);
        __syncthreads();
#pragma unroll
        for (int k8 = 0; k8 < 8; ++k8) { const int q_ = tid + 512 * k8, jj = q_ >> 4, ch = q_ & 15, i = i0 + jj; const bool valid = (i >= 0) && (i < Ls);
            u32x4 kv = {0u, 0u, 0u, 0u}, vv = {0u, 0u, 0u, 0u};
            if (valid) { const bf16_t* src = Bb + (size_t)(r + dil * i) * DSA_QKV + qcol + 8 * ch; kv = *(const u32x4*)(src + 3072); vv = *(const u32x4*)(src + 6144); }
            *(LAS u32x4*)(Kt + jj * DSA_TP + 16 * ch) = kv; *(LAS u32x4*)(Vt + jj * DSA_TP + 16 * ch) = vv; }
        __syncthreads();
        f32x4 sa[10];
#pragma unroll
        for (int cb = 0; cb < 10; ++cb) { sa[cb] = (f32x4){0.f, 0.f, 0.f, 0.f};
#pragma unroll
            for (int ks = 0; ks < 4; ++ks) { const bf16x8 Af = *(const LAS bf16x8*)(Kt + (16 * (w + cb) + i15) * DSA_TP + (32 * ks + 8 * kq) * 2);
                sa[cb] = __builtin_amdgcn_mfma_f32_16x16x32_bf16(Af, Qf[ks], sa[cb], 0, 0, 0); } }
        float m = -1e30f;
#pragma unroll
        for (int cb = 0; cb < 10; ++cb)
#pragma unroll
            for (int e = 0; e < 4; ++e) { const int jrel = 16 * cb + 4 * kq + e - i15, ki = i0 + 16 * (w + cb) + 4 * kq + e;
                const bool ok = (jrel >= 0) && (jrel <= 128) && (ki >= 0) && (ki < Ls);
                sa[cb][e] = ok ? sa[cb][e] : -1e30f; m = fmaxf(m, sa[cb][e]); }
        m = fmaxf(m, shx(m, 16, lane)); m = fmaxf(m, shx(m, 32, lane));
        float l = 0.f;
#pragma unroll
        for (int cb = 0; cb < 10; ++cb)
#pragma unroll
            for (int e = 0; e < 4; ++e) { const float pe = __expf(sa[cb][e] - m); sa[cb][e] = pe; l += pe; }
        l += shx(l, 16, lane); l += shx(l, 32, lane);
        f32x4 oa[8];
#pragma unroll
        for (int db = 0; db < 8; ++db) oa[db] = (f32x4){0.f, 0.f, 0.f, 0.f};
        unsigned vtb = lds_addr(Vt + (16 * w + 4 * kq + qq) * DSA_TP + (4 * p) * 2); asm volatile("" : "+v"(vtb));
#pragma unroll
        for (int s5 = 0; s5 < 5; ++s5) {
            u32x4 pw; pw.x = pk2(sa[2 * s5][0], sa[2 * s5][1]); pw.y = pk2(sa[2 * s5][2], sa[2 * s5][3]); pw.z = pk2(sa[2 * s5 + 1][0], sa[2 * s5 + 1][1]); pw.w = pk2(sa[2 * s5 + 1][2], sa[2 * s5 + 1][3]);
            const bf16x8 Pf = __builtin_bit_cast(bf16x8, pw);
#pragma unroll
            for (int db = 0; db < 8; ++db) { const unsigned a0 = vtb + (32 * s5) * DSA_TP + (16 * db) * 2;
                oa[db] = __builtin_amdgcn_mfma_f32_16x16x32_bf16(tr_read2(a0, a0 + 16 * DSA_TP), Pf, oa[db], 0, 0, 0); } }
        const float inv = 1.0f / l;
        float* orow = PO + ((size_t)g * MTOK + (size_t)b * SEQ + qpos) * DSA_OUT + hd * DSA_HD + 4 * kq;
#pragma unroll
        for (int db = 0; db < 8; ++db) *(f32x4*)(orow + 16 * db) = oa[db] * inv;
        if (kq == 0) LSE[((size_t)g * MTOK + (size_t)b * SEQ + qpos) * DSA_H + hd] = m + __logf(l);
    }
    __syncthreads();
}
__device__ __forceinline__ void dsa_merge(const Frame& F, const float* __restrict__ PO, const float* __restrict__ LSE, bf16_t* __restrict__ O) {
    const size_t n8 = (size_t)MTOK * DSA_OUT / 8;
    for (size_t i = (size_t)F.bid * NTHREADS + F.tid; i < n8; i += (size_t)F.G * NTHREADS) {
        const size_t row = i >> 7; const int hd = (int)(i & 127) >> 4;
        const float l0 = LSE[row * DSA_H + hd], l1 = LSE[((size_t)MTOK + row) * DSA_H + hd], l2 = LSE[((size_t)2 * MTOK + row) * DSA_H + hd];
        const float mx = fmaxf(l0, fmaxf(l1, l2));
        float w0 = __expf(l0 - mx), w1 = __expf(l1 - mx), w2 = __expf(l2 - mx); const float inv = 1.0f / (w0 + w1 + w2); w0 *= inv; w1 *= inv; w2 *= inv;
        const f32x4* p0 = (const f32x4*)(PO + i * 8); const f32x4* p1 = (const f32x4*)(PO + (size_t)MTOK * DSA_OUT + i * 8); const f32x4* p2 = (const f32x4*)(PO + (size_t)2 * MTOK * DSA_OUT + i * 8);
        const f32x4 a = p0[0] * w0 + p1[0] * w1 + p2[0] * w2, bq = p0[1] * w0 + p1[1] * w1 + p2[1] * w2;
        u32x4 o; o.x = pk2(a[0], a[1]); o.y = pk2(a[2], a[3]); o.z = pk2(bq[0], bq[1]); o.w = pk2(bq[2], bq[3]);
        *(u32x4*)(O + i * 8) = o;
    }
}
#ifndef MK_PER_PHASE
#define MK_PER_PHASE 0
#endif
constexpr int N_PHASES = DEPTH * 13;
struct Args { const float* in[28]; float* out; unsigned char* ws; int ph_lo, ph_hi; float rope_inv[64]; };
enum { I_X = 0, I_C, I_ADAW, I_ADAB, I_NORMG, I_F1I, I_F1O, I_F2I, I_F2O, I_SWIN, I_SLRE, I_SLIM, I_SLDT, I_SBRE, I_SBIM, I_SCRE, I_SCIM, I_SD, I_SWOUT,
       I_GWIN, I_GWG, I_GBG, I_GNG, I_GWO, I_DWIN, I_DQN, I_DKN, I_DWO };

__device__ __forceinline__ bool relaunder(Frame& F, int wave0) {
    int l_; asm volatile("v_mbcnt_lo_u32_b32 %0, -1, 0\n\tv_mbcnt_hi_u32_b32 %0, -1, %0" : "=v"(l_));
    int w_ = wave0; asm volatile("" : "+s"(w_));
    F.lane = l_; F.wave = w_; F.tid = w_ * 64 + l_;
    int b_ = blockIdx.x, g_ = gridDim.x; asm volatile("" : "+s"(b_), "+s"(g_)); F.bid = b_; F.G = g_; return true;
}
__device__ __forceinline__ const Args* args_ptr() { const Args* p = (const Args*)__builtin_amdgcn_kernarg_segment_ptr(); asm volatile("" : "+s"(p)); return p; }
__global__ void __launch_bounds__(NTHREADS, 2) fwd(Args a) {
    extern __shared__ __attribute__((aligned(16))) unsigned char lds_raw[];
    Frame F;
    F.lds = (LAS unsigned char*)lds_raw; F.tid = threadIdx.x; F.lane = F.tid & 63; F.wave = __builtin_amdgcn_readfirstlane(F.tid >> 6); F.G = gridDim.x; F.bid = blockIdx.x;
    if (F.tid < 16) ((LAS unsigned*)(F.lds + LDS_MISC))[F.tid] = 0u;
    __syncthreads();
    unsigned char* ws0 = a.ws;
    XcdBarrier bar; bar.bar = (unsigned*)(ws0 + WS_CTL); bar.x = 0; bar.st = (volatile LAS unsigned*)(F.lds + LDS_MISC);
    if (!MK_PER_PHASE) bar = xcd_barrier_post((unsigned*)(ws0 + WS_CTL), (volatile LAS unsigned*)(F.lds + LDS_MISC));
    const int lo = a.ph_lo, hi = a.ph_hi, wave0 = F.wave;
    int ph = 0;
#define PH_ON (ph >= lo && ph < hi && relaunder(F, wave0))
#define PH_END do { if (!MK_PER_PHASE && ph >= lo && ph + 1 < hi) { XcdBarrier b2_ = bar; asm volatile("" : "+s"(b2_.bar)); xcd_barrier(b2_); } ++ph; } while (0)

#define AP (args_ptr())
#define WS(off) (AP->ws + (off))
#define X (AP->out)
#define MOD ((float*)WS(WS_MOD))
#define COS ((float*)WS(WS_COS))
#define SIN ((float*)WS(WS_SIN))
#define W1I ((bf16_t*)WS(WS_W1I))
#define W1O ((bf16_t*)WS(WS_W1O))
#define W2I ((bf16_t*)WS(WS_W2I))
#define W2O ((bf16_t*)WS(WS_W2O))
#define WMI ((bf16_t*)WS(WS_WMI))
#define WMO ((bf16_t*)WS(WS_WMO))
#define H ((bf16_t*)WS(WS_H))
#define B1 ((bf16_t*)WS(WS_B1))
#define IN(i) (AP->in[i])
    constexpr int NCOL = NMOD * D;

#pragma unroll 1
    for (int layer = 0; layer < DEPTH; ++layer) {
        const int kind = layer % 3, jm = layer / 3;
#define modl (MOD + (size_t)layer * BATCH * NCOL)
        if (PH_ON) {
            if (layer == 0) { mod_phase(F, IN(I_C), IN(I_ADAW), IN(I_ADAB), MOD); rope_phase(F, AP->rope_inv, COS, SIN); }
            convert_matrix<1>(F, IN(I_F1I) + (size_t)layer * D * 2 * DFF, D, 2 * DFF, W1I, DFF);
            convert_matrix<0>(F, IN(I_F1O) + (size_t)layer * DFF * D, DFF, D, W1O, 0);
            convert_matrix<1>(F, IN(I_F2I) + (size_t)layer * D * 2 * DFF, D, 2 * DFF, W2I, DFF);
            convert_matrix<0>(F, IN(I_F2O) + (size_t)layer * DFF * D, DFF, D, W2O, 0);
            if (kind == 0) { convert_matrix<0>(F, IN(I_SWIN) + (size_t)jm * D * D, D, D, WMI, 0); convert_matrix<1>(F, IN(I_SWOUT) + (size_t)jm * D * 2 * D, D, 2 * D, WMO, D); }
            else if (kind == 1) { convert_matrix<0>(F, IN(I_GWIN) + (size_t)jm * D * GLA_NPROJ, D, GLA_NPROJ, WMI, 0); zero_bf16(F, WMI + (size_t)GLA_NPROJ * D, (size_t)(GLA_NPAD - GLA_NPROJ) * D / 8);
                                  convert_matrix<0>(F, IN(I_GWO) + (size_t)jm * GLA_DV * D, GLA_DV, D, WMO, 0); }
            else { convert_matrix<0>(F, IN(I_DWIN) + (size_t)jm * D * DSA_QKV, D, DSA_QKV, WMI, 0); convert_matrix<0>(F, IN(I_DWO) + (size_t)jm * DSA_OUT * D, DSA_OUT, D, WMO, 0); }
        }
        PH_END;
#pragma unroll 1
        for (int s = 0; s < 3; ++s) {
#define Xsrc ((layer == 0 && s == 0) ? IN(I_X) : (const float*)X)
            if (PH_ON) norm_phase(F, Xsrc, IN(I_NORMG) + (size_t)(layer * 3 + s) * D, modl + (3 * s) * D, modl + (3 * s + 1) * D, NCOL, H);
            PH_END;
            const int nin = (s != 1) ? 2 * DFF : (kind == 0 ? D : kind == 1 ? GLA_NPAD : DSA_QKV);
            if (PH_ON) {
                if (s != 1) { pg8::Gemm g{H, (s == 0) ? W1I : W2I, MTOK, 2 * DFF, D}; pg8::StaticOrder S; S.init(MTOK, 2 * DFF, F.G, F.bid);
                    pg8::EpiSwiGLU E{B1, DFF}; pg8::gemm_phase<pg8::EpiSwiGLU, pg8::StaticOrder, true, true>(F.lds, g, S, E, F.tid); }
                else { pg8::Gemm g{H, WMI, MTOK, nin, D}; pg8::StaticOrder S; S.init(MTOK, nin, F.G, F.bid);
                    pg8::EpiBf16P E{B1, nin}; pg8::gemm_phase<pg8::EpiBf16P, pg8::StaticOrder, true, true>(F.lds, g, S, E, F.tid); }
            }
            PH_END;
            if (s == 1) {
                if (kind == 0) {

                    if (PH_ON) s5_scan<1>(F, jm, B1, IN(I_SLRE), IN(I_SLIM), IN(I_SLDT), IN(I_SBRE), IN(I_SBIM), IN(I_SCRE), IN(I_SCIM), (float*)WS(WS_S5E), (float*)WS(S5_YF), (float*)WS(S5_YB));
                    PH_END;
                    if (PH_ON) s5_scan<2>(F, jm, B1, IN(I_SLRE), IN(I_SLIM), IN(I_SLDT), IN(I_SBRE), IN(I_SBIM), IN(I_SCRE), IN(I_SCIM), (float*)WS(WS_S5E), (float*)WS(S5_YF), (float*)WS(S5_YB));
                    PH_END;
                    if (PH_ON) s5_post(F, (float*)WS(S5_YF), (float*)WS(S5_YB), B1, IN(I_SD) + (size_t)jm * D, H);
                    PH_END;
                } else if (kind == 1) {

                    if (PH_ON) gla_a(F, jm, B1, IN(I_GWG), IN(I_GBG), (bf16_t*)WS(GLA_QD), (bf16_t*)WS(GLA_KL), (bf16_t*)WS(GLA_ATT), (float*)WS(GLA_DEC));
                    PH_END;
                    if (PH_ON) gla_b(F, B1, (bf16_t*)WS(GLA_QD), (bf16_t*)WS(GLA_KL), (bf16_t*)WS(GLA_ATT), (float*)WS(GLA_DEC), (bf16_t*)WS(GLA_OD));
                    PH_END;
                    if (PH_ON) gla_c(F, B1, (bf16_t*)WS(GLA_OD), IN(I_GNG) + (size_t)jm * GLA_DV, H);
                    PH_END;
                } else {

                    if (PH_ON) dsa_norm(F, B1, IN(I_DQN) + (size_t)jm * DSA_G * DSA_HD, IN(I_DKN) + (size_t)jm * DSA_G * DSA_HD, COS, SIN);
                    PH_END;
                    if (PH_ON) dsa_attn(F, B1, (float*)WS(DSA_PO), (float*)WS(DSA_LSE));
                    PH_END;
                    if (PH_ON) dsa_merge(F, (float*)WS(DSA_PO), (float*)WS(DSA_LSE), H);
                    PH_END;
                }
            }
            if (PH_ON) {
                if (s == 1 && kind == 0) { pg8::Gemm g{H, WMO, MTOK, 2 * D, D}; pg8::StaticOrder S; S.init(MTOK, 2 * D, F.G, F.bid);
                    pg8::EpiGLURes E{Xsrc, X, D, modl + 5 * D, NCOL, SEQ}; pg8::gemm_phase<pg8::EpiGLURes, pg8::StaticOrder, true, true>(F.lds, g, S, E, F.tid); }
                else { const int kout = (s != 1) ? DFF : (kind == 1 ? GLA_DV : DSA_OUT);
                    pg8::Gemm g{(s != 1) ? (const bf16_t*)B1 : (const bf16_t*)H, (s == 0) ? W1O : (s == 2) ? W2O : WMO, MTOK, D, kout}; pg8::StaticOrder S; S.init(MTOK, D, F.G, F.bid);
                    pg8::EpiRes E{Xsrc, X, D, modl + (3 * s + 2) * D, NCOL, (s != 1) ? 0.5f : 1.0f, SEQ}; pg8::gemm_phase<pg8::EpiRes, pg8::StaticOrder, true, true>(F.lds, g, S, E, F.tid); }
            }
            PH_END;
        }
    }
#undef PH_ON
#undef PH_END
#undef AP
#undef WS
#undef X
#undef MOD
#undef COS
#undef SIN
#undef W1I
#undef W1O
#undef W2I
#undef W2O
#undef WMI
#undef WMO
#undef H
#undef B1
#undef IN
#undef modl
#undef Xsrc
}

extern "C" void kernel_launch(void* const* d_in, const int* in_sizes, int n_in, void* d_out, int out_size, void* d_ws, size_t ws_size, hipStream_t stream) {
    static int grid = 0;
    if (grid == 0) {
        if (n_in != 28 || in_sizes[0] != MTOK * D || out_size != MTOK * D || ws_size < WS_END) {
            fprintf(stderr, "kernel_launch: unexpected problem (n_in %d, in0 %d, out %d, ws %zu < %zu?); nothing launched\n", n_in, n_in > 0 ? in_sizes[0] : -1, out_size, ws_size, (size_t)WS_END); grid = -1; return; }
        int dev = 0, cus = 0, per_cu = 0;
        if (hipGetDevice(&dev) != hipSuccess || hipDeviceGetAttribute(&cus, hipDeviceAttributeMultiprocessorCount, dev) != hipSuccess) { grid = -1; return; }
        if (hipFuncSetAttribute((const void*)fwd, hipFuncAttributeMaxDynamicSharedMemorySize, LDS_BYTES) != hipSuccess) { fprintf(stderr, "kernel_launch: hipFuncSetAttribute failed\n"); grid = -1; return; }
        if (hipOccupancyMaxActiveBlocksPerMultiprocessor(&per_cu, (const void*)fwd, NTHREADS, LDS_BYTES) != hipSuccess || per_cu < 1) { fprintf(stderr, "kernel_launch: occupancy query says %d blocks per CU\n", per_cu); }
        (void)hipGetLastError();
        grid = cus;
    }
    if (grid < 0) return;
    if (hipMemsetAsync((char*)d_ws + WS_CTL, 0, CTL_ZERO_BYTES, stream) != hipSuccess) return;
    Args a{};
    for (int i = 0; i < 28; ++i) a.in[i] = (const float*)d_in[i];
    a.out = (float*)d_out; a.ws = (unsigned char*)d_ws;
    for (int j = 0; j < 64; ++j) a.rope_inv[j] = (float)pow(10000.0, -(double)j / 64.0);
#if MK_PER_PHASE
    for (int p = 0; p < N_PHASES; ++p) { a.ph_lo = p; a.ph_hi = p + 1; hipLaunchKernelGGL(fwd, dim3(grid), dim3(NTHREADS), LDS_BYTES, stream, a); }
#else
    a.ph_lo = 0; a.ph_hi = N_PHASES;
    hipLaunchKernelGGL(fwd, dim3(grid), dim3(NTHREADS), LDS_BYTES, stream, a);
#endif
}
```

```cpp
#include <hip/hip_runtime.h>
#include <cstdio>
#include <cstdint>
#include <cmath>
#define XB_TMO      128
#define XB_XCNT(j)  (256  + 64 * (j))
#define XB_XSUB(j)  (1280 + 64 * (j))
#define XB_XGEN(j)  (2304 + 64 * (j))
#define XB_TOP      3328
#define XB_TOPGEN   3392
#define XCD_BAR_WORDS 3456
#define XB_SPIN_CAP (1u << 21)
#define LAS __attribute__((address_space(3)))

__device__ __forceinline__ unsigned xb_ld(unsigned* p)              { return __hip_atomic_load(p, __ATOMIC_RELAXED, __HIP_MEMORY_SCOPE_AGENT); }
__device__ __forceinline__ unsigned xb_add(unsigned* p, unsigned v) { return __hip_atomic_fetch_add(p, v, __ATOMIC_RELAXED, __HIP_MEMORY_SCOPE_AGENT); }
__device__ __forceinline__ unsigned xb_xcc_id() { return (unsigned)__builtin_amdgcn_s_getreg((3 << 11) | 20) & 0xFu; }
#define XB_SPIN(cond, bar) do { unsigned _sp = 0; while (cond) { __builtin_amdgcn_s_sleep(1); \
    if ((++_sp & 255u) == 0u) { if (xb_ld(&(bar)[XB_TMO])) break; if (_sp > XB_SPIN_CAP) { atomicAdd(&(bar)[XB_TMO], 1u); break; } } } } while (0)

struct XcdBarrier {
    unsigned* bar; unsigned x;
    volatile LAS unsigned* st;
};

__device__ __forceinline__ XcdBarrier xcd_barrier_post(unsigned* bar, volatile LAS unsigned* st) {
    XcdBarrier b; b.bar = bar; b.x = xb_xcc_id(); b.st = st;
    if (threadIdx.x == 0) (void)xb_add(&bar[XB_XCNT(b.x)], 1u);
    return b;
}
__device__ __forceinline__ void xcd_barrier_complete(unsigned* bar, unsigned x, unsigned& nloc, unsigned& nx) {
    const unsigned G = gridDim.x * gridDim.y * gridDim.z;
    unsigned sum, cnt, mine, sp = 0u;
    for (;;) {
        sum = 0u; cnt = 0u; mine = 0u;
#pragma unroll
        for (unsigned j = 0; j < 16; ++j) { const unsigned c = xb_ld(&bar[XB_XCNT(j)]); sum += c; cnt += (c > 0u) ? 1u : 0u; mine = (j == x) ? c : mine; }
        if (sum == G) break;
        __builtin_amdgcn_s_sleep(1);
        if ((++sp & 255u) == 0u) { if (xb_ld(&bar[XB_TMO])) break; if (sp > XB_SPIN_CAP) { atomicAdd(&bar[XB_TMO], 1u); break; } }
    }
    nloc = mine > 0u ? mine : 1u; nx = cnt > 0u ? cnt : 1u;
}

__device__ __forceinline__ void xcd_barrier(const XcdBarrier& b) {
    asm volatile("s_waitcnt vmcnt(0)" ::: "memory");
    __syncthreads();
    if (threadIdx.x == 0) {
        unsigned* bar = b.bar;
        __builtin_amdgcn_s_waitcnt(0);
        unsigned nloc = b.st[0], nx = b.st[1];
        if (nloc == 0u) { xcd_barrier_complete(bar, b.x, nloc, nx); b.st[0] = nloc; b.st[1] = nx; }
        const unsigned old = xb_add(&bar[XB_XSUB(b.x)], 1u);
        const unsigned gen = old / nloc;
        if (old + 1u == (gen + 1u) * nloc) {
            __builtin_amdgcn_fence(__ATOMIC_RELEASE, "agent");
            asm volatile("s_waitcnt vmcnt(0)" ::: "memory");
            const unsigned og = xb_add(&bar[XB_TOP], 1u);
            const unsigned tg = og / nx;
            if (og + 1u == (tg + 1u) * nx) xb_add(&bar[XB_TOPGEN], 1u);
            else XB_SPIN(xb_ld(&bar[XB_TOPGEN]) == tg, bar);
            __builtin_amdgcn_fence(__ATOMIC_ACQUIRE, "agent");
            xb_add(&bar[XB_XGEN(b.x)], 1u);
            asm volatile("s_waitcnt vmcnt(0)" ::: "memory");
        } else {
            XB_SPIN(xb_ld(&bar[XB_XGEN(b.x)]) == gen, bar);
            __builtin_amdgcn_fence(__ATOMIC_ACQUIRE, "agent");
            asm volatile("s_waitcnt vmcnt(0)" ::: "memory");
        }
    }
    __syncthreads();
}
namespace pg8 {
#define PG8_LAS __attribute__((address_space(3)))
typedef unsigned short bf16_t;
typedef short bf16x8 __attribute__((ext_vector_type(8)));
typedef float f32x4 __attribute__((ext_vector_type(4)));
typedef unsigned u32x4 __attribute__((ext_vector_type(4)));
typedef unsigned u32x2 __attribute__((ext_vector_type(2)));
constexpr int BM = 256, BK = 64, HALF = 128, HTB = HALF * BK * 2  , STAGE_BYTES = 8 * HTB, NXCD = 8, WGM = 8;

__host__ __device__ __forceinline__ int lds_byte(int r, int c) { const int st = (r >> 4) * 2 + (c >> 5), rr = r & 15, cc = c & 31, ob = rr * 64 + cc * 2; return st * 1024 + (ob ^ (((ob >> 9) & 1) << 5)); }
__host__ __device__ __forceinline__ void stage_rc(int b, int& R, int& C) { const int st = b / 1024, sb = b % 1024, swz = sb ^ (((sb >> 9) & 1) << 5); R = (st >> 1) * 16 + swz / 64; C = (st & 1) * 32 + (swz % 64) / 2; }
__host__ __device__ __forceinline__ int perm32(int rho) { const int n = rho >> 4, i = rho & 15; return 8 * (i >> 2) + 4 * n + (i & 3); }

struct Unit { int pm, pn; };
struct Gemm { const bf16_t* A; const bf16_t* Bt; int M, N, K; };

struct StaticOrder {
    int nM, nN, nwg, G, c, wgm;
    __host__ __device__ void init(int M, int N, int G_, int c_, int wgm_ = WGM) { nM = M / BM; nN = N / BM; nwg = nM * nN; G = G_; c = c_; wgm = wgm_; }
    __host__ __device__ bool next(int i, Unit& u) const {
        const long L = (long)i * G + c; if (L >= nwg) return false;
        int wgid = (int)L; { const int q = nwg / NXCD, r = nwg % NXCD, xcd = wgid % NXCD, off = wgid / NXCD; wgid = (xcd < r ? xcd * (q + 1) : r * (q + 1) + (xcd - r) * q) + off; }
        const int nig = wgm * nN, gid = wgid / nig, fm = gid * wgm, gsz = (nM - fm) < wgm ? (nM - fm) : wgm;
        u.pm = fm + ((wgid % nig) % gsz); u.pn = (wgid % nig) / gsz; return true;
    }
    __device__ __forceinline__ void a_ready(const Unit&) const {}
    __device__ __forceinline__ void done(const Unit&) const {}
};
typedef __bf16 bf16v2 __attribute__((ext_vector_type(2)));
__device__ __forceinline__ unsigned cvt_pk_bf16(float lo, float hi) { bf16v2 v; v[0] = (__bf16)lo; v[1] = (__bf16)hi; return __builtin_bit_cast(unsigned, v); }
typedef float f32x2 __attribute__((ext_vector_type(2)));
__device__ __forceinline__ float sigmoid_fast(float x) { return __builtin_amdgcn_rcpf(1.0f + __expf(-x)); }
struct EpiSwiGLU {
    static constexpr bool PERM = true, AFTER_DRAIN = false;
    bf16_t* O; int ldc;
    __device__ __forceinline__ void operator()(const f32x4 (&acc)[2][2][4][2], const Unit& u, int wr, int wc, int fr, int fq) const {
        const int row0 = u.pm * BM + wr * 64 + fr, col0 = u.pn * HALF + wc * 32 + 8 * fq;
#pragma unroll
        for (int ai = 0; ai < 2; ++ai)
#pragma unroll
            for (int m = 0; m < 4; ++m) { bf16_t* rowp = O + (size_t)(row0 + ai * HALF + m * 16) * ldc + col0;
                float v[8];
#pragma unroll
                for (int n = 0; n < 2; ++n)
#pragma unroll
                    for (int i = 0; i < 4; ++i) { const float g = acc[ai][0][m][n][i], uu = acc[ai][1][m][n][i]; v[4 * n + i] = g * sigmoid_fast(g) * uu; }
                u32x4 w; w.x = cvt_pk_bf16(v[0], v[1]); w.y = cvt_pk_bf16(v[2], v[3]); w.z = cvt_pk_bf16(v[4], v[5]); w.w = cvt_pk_bf16(v[6], v[7]);
                *(u32x4*)rowp = w; }
    }
};
struct EpiBf16P {
    static constexpr bool PERM = true, AFTER_DRAIN = false;
    bf16_t* O; int ldc;
    __device__ __forceinline__ void operator()(const f32x4 (&acc)[2][2][4][2], const Unit& u, int wr, int wc, int fr, int fq) const {
        const int row0 = u.pm * BM + wr * 64 + fr, col0 = u.pn * BM + wc * 32 + 8 * fq;
#pragma unroll
        for (int ai = 0; ai < 2; ++ai)
#pragma unroll
            for (int m = 0; m < 4; ++m) { bf16_t* rowp = O + (size_t)(row0 + ai * HALF + m * 16) * ldc + col0;
#pragma unroll
                for (int bj = 0; bj < 2; ++bj) { const f32x4 v0 = acc[ai][bj][m][0], v1 = acc[ai][bj][m][1];
                    u32x4 w; w.x = cvt_pk_bf16(v0[0], v0[1]); w.y = cvt_pk_bf16(v0[2], v0[3]); w.z = cvt_pk_bf16(v1[0], v1[1]); w.w = cvt_pk_bf16(v1[2], v1[3]);
                    *(u32x4*)(rowp + bj * HALF) = w; } }
    }
};
struct EpiRes {
    static constexpr bool PERM = false, AFTER_DRAIN = false;
    float* x; int ldc; const float* gate; int gate_bstride; float gscale; int rows_per_batch;
    __device__ __forceinline__ void operator()(const f32x4 (&acc)[2][2][4][2], const Unit& u, int wr, int wc, int fr, int fq) const {
        const int row0 = u.pm * BM + wr * 64 + fr, col0 = u.pn * BM + wc * 32 + 4 * fq;
        const float* gp = gate + (size_t)((u.pm * BM) / rows_per_batch) * gate_bstride + col0;
        f32x4 gv[2][2];
#pragma unroll
        for (int bj = 0; bj < 2; ++bj)
#pragma unroll
            for (int n = 0; n < 2; ++n) gv[bj][n] = *(const f32x4*)(gp + bj * HALF + n * 16) * gscale;
#pragma unroll
        for (int ai = 0; ai < 2; ++ai)
#pragma unroll
        for (int mh = 0; mh < 2; ++mh) {
            f32x4 bs[2][2][2];
#pragma unroll
            for (int mm = 0; mm < 2; ++mm) { const size_t off = (size_t)(row0 + ai * HALF + (2 * mh + mm) * 16) * ldc + col0;
#pragma unroll
                for (int bj = 0; bj < 2; ++bj)
#pragma unroll
                    for (int n = 0; n < 2; ++n) bs[mm][bj][n] = *(const f32x4*)(x + off + bj * HALF + n * 16); }
#pragma unroll
            for (int mm = 0; mm < 2; ++mm) { const size_t off = (size_t)(row0 + ai * HALF + (2 * mh + mm) * 16) * ldc + col0;
#pragma unroll
                for (int bj = 0; bj < 2; ++bj)
#pragma unroll
                    for (int n = 0; n < 2; ++n) *(f32x4*)(x + off + bj * HALF + n * 16) = bs[mm][bj][n] + gv[bj][n] * acc[ai][bj][2 * mh + mm][n]; }
            asm volatile("" ::: "memory"); }
    }
};
struct EpiGLURes {
    static constexpr bool PERM = true, AFTER_DRAIN = false;
    float* x; int ldc; const float* gate; int gate_bstride; int rows_per_batch;
    __device__ __forceinline__ void operator()(const f32x4 (&acc)[2][2][4][2], const Unit& u, int wr, int wc, int fr, int fq) const {
        const int row0 = u.pm * BM + wr * 64 + fr, col0 = u.pn * HALF + wc * 32 + 8 * fq;
        const float* gp = gate + (size_t)((u.pm * BM) / rows_per_batch) * gate_bstride + col0;
        const f32x4 gv0 = *(const f32x4*)gp, gv1 = *(const f32x4*)(gp + 4);
#pragma unroll
        for (int ai = 0; ai < 2; ++ai) {
            f32x4 b0[4], b1[4];
#pragma unroll
            for (int m = 0; m < 4; ++m) { const size_t off = (size_t)(row0 + ai * HALF + m * 16) * ldc + col0; b0[m] = *(const f32x4*)(x + off); b1[m] = *(const f32x4*)(x + off + 4); }
#pragma unroll
            for (int m = 0; m < 4; ++m) { const size_t off = (size_t)(row0 + ai * HALF + m * 16) * ldc + col0;
                f32x4 y0, y1;
#pragma unroll
                for (int i = 0; i < 4; ++i) { y0[i] = acc[ai][0][m][0][i] * sigmoid_fast(acc[ai][1][m][0][i]); y1[i] = acc[ai][0][m][1][i] * sigmoid_fast(acc[ai][1][m][1][i]); }
                *(f32x4*)(x + off) = b0[m] + gv0 * y0; *(f32x4*)(x + off + 4) = b1[m] + gv1 * y1; }
            asm volatile("" ::: "memory"); }
    }
};
template <class Epi, class Sched, bool ALIGN_EPI = false, bool SP2 = false>
__device__ __forceinline__ void gemm_phase(PG8_LAS unsigned char* lds, const Gemm g, const Sched& S, const Epi& E, const int tid) {
    const int wid = __builtin_amdgcn_readfirstlane(tid >> 6), lane = tid & 63, wr = wid >> 2, wc = wid & 3, fr = lane & 15, fq = lane >> 4;
    const int K = g.K, nt = K / BK;
    unsigned voffA[2], voffB[2];
#pragma unroll
    for (int i = 0; i < 2; ++i) { int R, C; stage_rc(tid * 16 + i * 8192, R, C); const int Rb = Epi::PERM ? ((R & ~31) + perm32(R & 31)) : R;
        voffA[i] = (unsigned)(R * K + C) * 2u; voffB[i] = (unsigned)(Rb * K + C) * 2u; }
    const size_t kstep = (size_t)(BK * 2);
    const size_t hstep = (size_t)HALF * K * 2;
    const size_t tstep = 2 * hstep;
    const unsigned ldsw = (unsigned)wid * 1024u;
    const int aoff = lds_byte(wr * 64 + fr, fq * 8), boff = lds_byte(wc * 32 + fr, fq * 8);
#define PG8_SA(b, h) (((b) * 2 + (h)) * HTB)
#define PG8_SB(b, h) ((4 + (b) * 2 + (h)) * HTB)
#define PG8_STAGE(bufoff, gbase, voff) do { _Pragma("unroll") for (int _i = 0; _i < 2; ++_i) \
        __builtin_amdgcn_global_load_lds((const unsigned*)((const char*)(gbase) + (voff)[_i]), (PG8_LAS unsigned*)(lds + (bufoff) + ldsw + _i * 8192), 16, 0, 0); } while (0)
#define PG8_LDA(dst, b, h) do { _Pragma("unroll") for (int m = 0; m < 4; ++m) _Pragma("unroll") for (int k = 0; k < 2; ++k) dst[m][k] = *(const PG8_LAS bf16x8*)(lds + PG8_SA(b, h) + aoff + m * 2048 + k * 1024); } while (0)
#define PG8_LDB(dst, b, h) do { _Pragma("unroll") for (int n = 0; n < 2; ++n) _Pragma("unroll") for (int k = 0; k < 2; ++k) dst[n][k] = *(const PG8_LAS bf16x8*)(lds + PG8_SB(b, h) + boff + n * 2048 + k * 1024); } while (0)
#define PG8_MMA(ai, bj, At, Bt) do { __builtin_amdgcn_s_setprio(1); _Pragma("unroll") for (int m = 0; m < 4; ++m) _Pragma("unroll") for (int n = 0; n < 2; ++n) _Pragma("unroll") for (int k = 0; k < 2; ++k) \
        acc[ai][bj][m][n] = __builtin_amdgcn_mfma_f32_16x16x32_bf16(Bt[n][k], At[m][k], acc[ai][bj][m][n], 0, 0, 0); __builtin_amdgcn_s_setprio(0); } while (0)
#define PG8_WAIT_V(n) asm volatile("s_waitcnt vmcnt(" #n ")" ::: "memory")
#define PG8_WAIT_L(n) asm volatile("s_waitcnt lgkmcnt(" #n ")" ::: "memory")
#define PG8_BAR __builtin_amdgcn_s_barrier()
#define PG8_SCHED __builtin_amdgcn_sched_barrier(0)
    Unit cur, nxt; int ui = 0;
    if (!S.next(0, cur)) return;
    f32x4 acc[2][2][4][2];
#pragma unroll
    for (int a = 0; a < 2; ++a)
#pragma unroll
        for (int b = 0; b < 2; ++b)
#pragma unroll
            for (int m = 0; m < 4; ++m)
#pragma unroll
                for (int n = 0; n < 2; ++n) acc[a][b][m][n] = (f32x4){0.f, 0.f, 0.f, 0.f};
    bf16x8 At[4][2], B0[2][2], B1[2][2];
    const char* cA = (const char*)g.A + (size_t)cur.pm * tstep; const char* cB = (const char*)g.Bt + (size_t)cur.pn * tstep;
    S.a_ready(cur);
    if constexpr (SP2) {
        PG8_STAGE(PG8_SB(0, 0), cB, voffB); PG8_STAGE(PG8_SB(0, 1), cB + hstep, voffB); PG8_STAGE(PG8_SA(0, 0), cA, voffA); PG8_STAGE(PG8_SA(0, 1), cA + hstep, voffA);
        if (wr == 1) PG8_BAR;
        PG8_WAIT_V(2); PG8_BAR;
        PG8_STAGE(PG8_SB(1, 0), cB + kstep, voffB); PG8_STAGE(PG8_SA(1, 0), cA + kstep, voffA); PG8_STAGE(PG8_SB(1, 1), cB + hstep + kstep, voffB);
        PG8_WAIT_V(6); PG8_BAR;
    } else {
        PG8_STAGE(PG8_SB(0, 0), cB, voffB); PG8_STAGE(PG8_SA(0, 0), cA, voffA); PG8_STAGE(PG8_SB(0, 1), cB + hstep, voffB); PG8_STAGE(PG8_SA(0, 1), cA + hstep, voffA);
        if (wr == 1) PG8_BAR;
        PG8_WAIT_V(4); PG8_BAR;
        PG8_STAGE(PG8_SB(1, 0), cB + kstep, voffB); PG8_STAGE(PG8_SA(1, 0), cA + kstep, voffA); PG8_STAGE(PG8_SB(1, 1), cB + hstep + kstep, voffB);
        PG8_WAIT_V(6); PG8_BAR;
    }
    for (;;) {
        const bool has_next = S.next(ui + 1, nxt);
        const char* nA = has_next ? (const char*)g.A + (size_t)nxt.pm * tstep : cA; const char* nB = has_next ? (const char*)g.Bt + (size_t)nxt.pn * tstep : cB;
        for (int t = 0; t < nt; t += 2) {
            const bool last = (t == nt - 2);
            const char* a1 = cA + (size_t)(t + 1) * kstep;
            const char* a2 = last ? nA : cA + (size_t)(t + 2) * kstep; const char* b2 = last ? nB : cB + (size_t)(t + 2) * kstep;
            const char* a3 = a2 + kstep; const char* b3 = b2 + kstep;
            if (last && has_next) S.a_ready(nxt);
            if constexpr (SP2) {
            PG8_LDB(B0, 0, 0); PG8_LDB(B1, 0, 1); PG8_SCHED; PG8_LDA(At, 0, 0); PG8_STAGE(PG8_SA(1, 1), a1 + hstep, voffA);
            PG8_WAIT_V(8); PG8_WAIT_L(0); PG8_BAR; PG8_MMA(0, 0, At, B0); PG8_MMA(0, 1, At, B1); PG8_BAR; PG8_SCHED;
            PG8_LDA(At, 0, 1); PG8_STAGE(PG8_SB(0, 0), b2, voffB); PG8_STAGE(PG8_SB(0, 1), b2 + hstep, voffB); PG8_STAGE(PG8_SA(0, 0), a2, voffA);
            PG8_WAIT_V(8); PG8_WAIT_L(0); PG8_BAR; PG8_MMA(1, 0, At, B0); PG8_MMA(1, 1, At, B1); PG8_BAR; PG8_SCHED;
            PG8_LDB(B0, 1, 0); PG8_LDB(B1, 1, 1); PG8_SCHED; PG8_LDA(At, 1, 0); PG8_STAGE(PG8_SA(0, 1), a2 + hstep, voffA);
            PG8_WAIT_V(8); PG8_WAIT_L(0); PG8_BAR; PG8_MMA(0, 0, At, B0); PG8_MMA(0, 1, At, B1); PG8_BAR; PG8_SCHED;
            PG8_LDA(At, 1, 1); PG8_STAGE(PG8_SB(1, 0), b3, voffB); PG8_STAGE(PG8_SB(1, 1), b3 + hstep, voffB); PG8_STAGE(PG8_SA(1, 0), a3, voffA);
            PG8_WAIT_V(8); PG8_WAIT_L(0); PG8_BAR; PG8_MMA(1, 0, At, B0); PG8_MMA(1, 1, At, B1); PG8_BAR; PG8_SCHED;
            } else {
            PG8_LDB(B0, 0, 0); PG8_SCHED; PG8_LDA(At, 0, 0); PG8_STAGE(PG8_SA(1, 1), a1 + hstep, voffA);
            PG8_WAIT_L(8); PG8_BAR; PG8_WAIT_L(0); PG8_MMA(0, 0, At, B0); PG8_BAR; PG8_SCHED;
            PG8_LDB(B1, 0, 1); PG8_STAGE(PG8_SB(0, 0), b2, voffB);
            PG8_BAR; PG8_WAIT_L(0); PG8_MMA(0, 1, At, B1); PG8_BAR;
            PG8_LDA(At, 0, 1); PG8_STAGE(PG8_SA(0, 0), a2, voffA);
            PG8_BAR; PG8_WAIT_L(0); PG8_MMA(1, 0, At, B0); PG8_BAR; PG8_SCHED;
            PG8_STAGE(PG8_SB(0, 1), b2 + hstep, voffB);
            PG8_WAIT_V(6); PG8_BAR; PG8_MMA(1, 1, At, B1); PG8_BAR;
            PG8_LDB(B0, 1, 0); PG8_SCHED; PG8_LDA(At, 1, 0); PG8_STAGE(PG8_SA(0, 1), a2 + hstep, voffA);
            PG8_WAIT_L(8); PG8_BAR; PG8_WAIT_L(0); PG8_MMA(0, 0, At, B0); PG8_BAR; PG8_SCHED;
            PG8_LDB(B1, 1, 1); PG8_STAGE(PG8_SB(1, 0), b3, voffB);
            PG8_BAR; PG8_WAIT_L(0); PG8_MMA(0, 1, At, B1); PG8_BAR;
            PG8_LDA(At, 1, 1); PG8_STAGE(PG8_SA(1, 0), a3, voffA);
            PG8_BAR; PG8_WAIT_L(0); PG8_MMA(1, 0, At, B0); PG8_BAR; PG8_SCHED;
            PG8_STAGE(PG8_SB(1, 1), b3 + hstep, voffB);
            PG8_WAIT_V(6); PG8_BAR; PG8_MMA(1, 1, At, B1); PG8_BAR;
            }
        }
        if constexpr (ALIGN_EPI) { if (wr == 0) PG8_BAR; }
        if constexpr (!Epi::AFTER_DRAIN) { E(acc, cur, wr, wc, fr, fq); S.done(cur); }
        if (!has_next) break;
#pragma unroll
        for (int a = 0; a < 2; ++a)
#pragma unroll
            for (int b = 0; b < 2; ++b)
#pragma unroll
                for (int m = 0; m < 4; ++m)
#pragma unroll
                    for (int n = 0; n < 2; ++n) acc[a][b][m][n] = (f32x4){0.f, 0.f, 0.f, 0.f};
        cur = nxt; cA = nA; cB = nB; ++ui;
        if constexpr (ALIGN_EPI) { if (wr == 1) PG8_BAR; }
    }
    PG8_WAIT_V(0);
    if constexpr (!ALIGN_EPI) { if (wr == 0) PG8_BAR; }
    PG8_BAR;
    if constexpr (Epi::AFTER_DRAIN) { E.fused(acc, cur, wr, wc, fr, fq, lds, wid, lane); S.done(cur); }
#undef PG8_SA
#undef PG8_SB
#undef PG8_STAGE
#undef PG8_LDA
#undef PG8_LDB
#undef PG8_MMA
#undef PG8_WAIT_V
#undef PG8_WAIT_L
#undef PG8_BAR
#undef PG8_SCHED
}
}
constexpr int D = 2048, BATCH = 2, SEQ = 16384, MTOK = BATCH * SEQ, DFF = 5632, NMOD = 9, DEPTH = 4;
constexpr int NWAVES = 8, NTHREADS = NWAVES * 64;
constexpr int SSM_G = 128, SSM_K = 16, SSM_P = 64, S5_NSEG = 8, S5_LSEG = SEQ / S5_NSEG;
constexpr int GLA_H = 4, GLA_DK = 1024, GLA_DV = 2048, GLA_DKH = 256, GLA_DVH = 512, GLA_RANK = 16, GLA_C = 64, GLA_NPROJ = 6176, GLA_NPAD = 6400, GLA_NCHUNK = SEQ / GLA_C;
constexpr int DSA_G = 3, DSA_H = 8, DSA_HD = 128, DSA_QKV = 9216, DSA_OUT = 1024;
constexpr size_t MiB = (size_t)1 << 20;
constexpr size_t WS_CTL = 0, CTL_ZERO_BYTES = 64 * 1024;
constexpr size_t WS_MOD = 1 * MiB;
constexpr size_t WS_COS = 2 * MiB, WS_SIN = 6 * MiB;
constexpr size_t WS_S5E = 10 * MiB;
constexpr size_t WS_W1I = 16 * MiB, WS_W1O = 60 * MiB, WS_W2I = 82 * MiB, WS_W2O = 126 * MiB, WS_WMI = 148 * MiB, WS_WMO = 184 * MiB;
constexpr size_t WS_H = 200 * MiB;
constexpr size_t WS_B1 = 328 * MiB;
constexpr size_t WS_B2 = 904 * MiB;
constexpr size_t WS_END = 1480 * MiB;
constexpr size_t S5_YF = WS_B2, S5_YB = WS_B2 + 256 * MiB;
constexpr size_t GLA_QD = WS_B2, GLA_KL = WS_B2 + 128 * MiB, GLA_ATT = WS_B2 + 256 * MiB, GLA_DEC = WS_B2 + 288 * MiB, GLA_OD = WS_B2 + 292 * MiB;
constexpr size_t DSA_PO = WS_B2, DSA_LSE = WS_B2 + 384 * MiB;
constexpr int LDS_BYTES = 160 * 1024 - 512;
constexpr int LDS_MISC = LDS_BYTES - 64;

typedef unsigned short bf16_t;
typedef short bf16x8 __attribute__((ext_vector_type(8)));
typedef short bf16x4 __attribute__((ext_vector_type(4)));
typedef float f32x4 __attribute__((ext_vector_type(4)));
typedef float f32x16 __attribute__((ext_vector_type(16)));
typedef unsigned u32x4 __attribute__((ext_vector_type(4)));
typedef unsigned u32x2 __attribute__((ext_vector_type(2)));

typedef __bf16 bf16v2_t __attribute__((ext_vector_type(2)));
__device__ __forceinline__ unsigned pk2(float lo, float hi) { bf16v2_t v; v[0] = (__bf16)lo; v[1] = (__bf16)hi; return __builtin_bit_cast(unsigned, v); }
__device__ __forceinline__ float bf_lo(unsigned w) { return __uint_as_float(w << 16); }
__device__ __forceinline__ float bf_hi(unsigned w) { return __uint_as_float(w & 0xffff0000u); }
__device__ __forceinline__ float bf2f(bf16_t b) { return __uint_as_float(((unsigned)b) << 16); }
#define LDS_WAIT() asm volatile("s_waitcnt lgkmcnt(0)" ::: "memory")
#define VM_WAIT() asm volatile("s_waitcnt vmcnt(0)" ::: "memory")

__device__ __forceinline__ void sincos_f(float x, float& s, float& c) {
    const float k = __builtin_rintf(x * 0.636619772367581343f);
    float r = __builtin_fmaf(-k, 1.5707963705062866f, x); r = __builtin_fmaf(-k, -4.371138828673793e-08f, r); r = __builtin_fmaf(-k, -1.7151245100058819e-15f, r);
    const float r2 = r * r;
    float sp = 2.7557319e-6f; sp = __builtin_fmaf(sp, r2, -1.9841270e-4f); sp = __builtin_fmaf(sp, r2, 8.3333333e-3f); sp = __builtin_fmaf(sp, r2, -1.6666667e-1f);
    const float sr = __builtin_fmaf(r * r2, sp, r);
    float cp = -2.7557319e-7f; cp = __builtin_fmaf(cp, r2, 2.4801587e-5f); cp = __builtin_fmaf(cp, r2, -1.3888889e-3f); cp = __builtin_fmaf(cp, r2, 4.1666667e-2f);
    const float cr = __builtin_fmaf(r2 * r2, cp, __builtin_fmaf(-0.5f, r2, 1.0f));
    const int q = ((int)k) & 3;
    s = (q == 0) ? sr : (q == 1) ? cr : (q == 2) ? -sr : -cr;
    c = (q == 0) ? cr : (q == 1) ? -sr : (q == 2) ? -cr : sr;
}

struct Frame {
    LAS unsigned char* lds;
    int tid, lane, wave, G, bid;
};

__device__ __forceinline__ float shx(float v, int o, int lane) { return __int_as_float(__builtin_amdgcn_ds_bpermute((lane ^ o) << 2, __float_as_int(v))); }
__device__ __forceinline__ float wave_sum(float v, int lane) {
#pragma unroll
    for (int o = 1; o < 64; o <<= 1) v += shx(v, o, lane);
    return v;
}
template <int MODE>
__device__ __forceinline__ void transpose_item(const float* __restrict__ W, int K, int N, bf16_t* __restrict__ WT, int NH, LAS float* scr, int item, int lane) {
    const int nblk = N / 32, kb = item / nblk, nb = item % nblk, k0 = 64 * kb, n0 = 32 * nb;
    int d0 = n0;
    if (MODE == 1) { const int bj = n0 / NH, jj = n0 % NH; d0 = 256 * (jj / 128) + 128 * bj + (jj % 128); }
#pragma unroll
    for (int i = 0; i < 8; ++i) { const int kk = 8 * i + (lane >> 3), nq = 4 * (lane & 7);
        const f32x4 v = *(const f32x4*)(W + (size_t)(k0 + kk) * N + n0 + nq);
        LAS float* d = scr + kk * 33 + nq; d[0] = v.x; d[1] = v.y; d[2] = v.z; d[3] = v.w; }
    LDS_WAIT(); asm volatile("" ::: "memory");
    const int c = lane & 7;
#pragma unroll
    for (int j = 0; j < 4; ++j) { const int n = (lane >> 3) + 8 * j; const LAS float* s = scr + (8 * c) * 33 + n;
        u32x4 o; o.x = pk2(s[0 * 33], s[1 * 33]); o.y = pk2(s[2 * 33], s[3 * 33]); o.z = pk2(s[4 * 33], s[5 * 33]); o.w = pk2(s[6 * 33], s[7 * 33]);
        *(u32x4*)(WT + (size_t)(d0 + n) * K + k0 + 8 * c) = o; }
    LDS_WAIT(); asm volatile("" ::: "memory");
}
template <int MODE>
__device__ __forceinline__ void convert_matrix(const Frame& F, const float* W, int K, int N, bf16_t* WT, int NH) {
    LAS float* scr = (LAS float*)(F.lds + F.wave * 16384);
    const int gw = F.bid * NWAVES + F.wave, NGW = F.G * NWAVES, nitems = (K / 64) * (N / 32);
    for (int it = gw; it < nitems; it += NGW) transpose_item<MODE>(W, K, N, WT, NH, scr, it, F.lane);
}
__device__ __forceinline__ void zero_bf16(const Frame& F, bf16_t* p, size_t n8) {
    unsigned zz = 0u; asm volatile("" : "+v"(zz)); const u32x4 z = {zz, zz, zz, zz};
    for (size_t i = (size_t)F.bid * NTHREADS + F.tid; i < n8; i += (size_t)F.G * NTHREADS) ((u32x4*)p)[i] = z;
}
__device__ __forceinline__ void mod_phase(const Frame& F, const float* __restrict__ c, const float* __restrict__ ada_w, const float* __restrict__ ada_b, float* __restrict__ mod) {
    constexpr int NCOL = NMOD * D, UPL = NCOL / 256, NUNIT = DEPTH * UPL;
    LAS float* red = (LAS float*)F.lds;
    LAS float* sact = (LAS float*)(F.lds + 16384);
    for (int i = F.tid; i < BATCH * D; i += NTHREADS) { const float cv = c[i]; sact[i] = cv / (1.0f + __expf(-cv)); }
    __syncthreads();
    for (int u = F.bid; u < NUNIT; u += F.G) {
        const int layer = u / UPL, n0 = (u % UPL) * 256 + 4 * F.lane;
        const float* Wp = ada_w + (size_t)layer * D * NCOL + n0;
        f32x4 a0 = {0.f, 0.f, 0.f, 0.f}, a1 = {0.f, 0.f, 0.f, 0.f};
        const int kbeg = F.wave * 256;
#pragma unroll 8
        for (int k = kbeg; k < kbeg + 256; ++k) {
            const f32x4 w = *(const f32x4*)(Wp + (size_t)k * NCOL);
            a0 += w * sact[k]; a1 += w * sact[D + k];
        }
        __syncthreads();
        *(LAS f32x4*)(red + (F.wave * 2 + 0) * 256 + 4 * F.lane) = a0;
        *(LAS f32x4*)(red + (F.wave * 2 + 1) * 256 + 4 * F.lane) = a1;
        __syncthreads();
        { const int b = F.tid >> 8, col = F.tid & 255; float s = 0.f;
#pragma unroll
          for (int w = 0; w < 8; ++w) s += red[(w * 2 + b) * 256 + col];
          const int n = (u % UPL) * 256 + col;
          mod[((size_t)layer * BATCH + b) * NCOL + n] = s + ada_b[(size_t)layer * NCOL + n]; }
    }
    __syncthreads();
}
__device__ __forceinline__ void rope_phase(const Frame& F, const float* __restrict__ invf, float* __restrict__ cs, float* __restrict__ sn) {
    for (int i = F.bid * NTHREADS + F.tid; i < SEQ * 64; i += F.G * NTHREADS) {
        const int pos = i >> 6, j = i & 63;
        const float ang = (float)pos * invf[j];
        float s, c; sincos_f(ang, s, c);
        cs[i] = c; sn[i] = s;
    }
}
__device__ __forceinline__ void norm_phase(const Frame& F, const float* __restrict__ X, const float* __restrict__ g, const float* __restrict__ shift, const float* __restrict__ scale, int bstride, bf16_t* __restrict__ H, float* __restrict__ xcopy) {
    const int gw = F.bid * NWAVES + F.wave, NGW = F.G * NWAVES;
    for (int r0 = gw * 16; r0 < MTOK; r0 += NGW * 16) {
        const int b = r0 / SEQ;
        f32x4 A[8], B[8];
#pragma unroll
        for (int j = 0; j < 8; ++j) { const int c = 4 * F.lane + 256 * j; const f32x4 gg = *(const f32x4*)(g + c), sc = *(const f32x4*)(scale + (size_t)b * bstride + c);
            A[j] = gg * (sc + 1.0f); B[j] = *(const f32x4*)(shift + (size_t)b * bstride + c); }
        for (int r = r0; r < r0 + 16; ++r) {
            const f32x4* xr = (const f32x4*)(X + (size_t)r * D) + F.lane;
            f32x4 v[8]; float s = 0.f;
#pragma unroll
            for (int j = 0; j < 8; ++j) { v[j] = xr[64 * j]; s += (v[j].x * v[j].x + v[j].y * v[j].y) + (v[j].z * v[j].z + v[j].w * v[j].w); }
            if (xcopy) { f32x4* xo = (f32x4*)(xcopy + (size_t)r * D) + F.lane;
#pragma unroll
                for (int j = 0; j < 8; ++j) xo[64 * j] = v[j]; }
            const float rstd = 1.0f / sqrtf(wave_sum(s, F.lane) * (1.0f / D) + 1e-6f);
            unsigned long long* o8 = (unsigned long long*)(H + (size_t)r * D) + F.lane;
#pragma unroll
            for (int j = 0; j < 8; ++j) { const f32x4 y = v[j] * rstd * A[j] + B[j];
                o8[64 * j] = (unsigned long long)pk2(y.x, y.y) | ((unsigned long long)pk2(y.z, y.w) << 32); }
        }
    }
}
template <int PASS>
__device__ __forceinline__ void s5_scan(const Frame& F, int jl, const bf16_t* __restrict__ U, const float* __restrict__ lam_re, const float* __restrict__ lam_im, const float* __restrict__ log_dt,
                                        const float* __restrict__ b_re, const float* __restrict__ b_im, const float* __restrict__ c_re, const float* __restrict__ c_im,
                                        float* __restrict__ E, bf16_t* __restrict__ YF, bf16_t* __restrict__ YB) {
    const int lane = F.lane, c = lane & 31, h = lane >> 5, i15 = lane & 15, kq = lane >> 4;
    const int gw = F.bid * NWAVES + F.wave, NGW = F.G * NWAVES;
    constexpr int NS = (PASS == 1) ? S5_NSEG - 1 : S5_NSEG;
    constexpr int NIT = SSM_G * 2 * NS;
    constexpr int TP = 272;
    LAS unsigned char* tile = F.lds + F.wave * (32 * TP);
    for (int it = gw; it < NIT; it += NGW) {
        const int rest_ = it >> 3, seg = rest_ % NS, dir = (rest_ / NS) & 1, g = 8 * (rest_ / (NS * 2)) + (it & 7);
        const int pb = (jl * 2 + dir) * SSM_G + g;
        const float dt = expf(log_dt[pb]);
        float ar[2], ai[2], Lr[2], Li[2], fr[2], fi[2];
#pragma unroll
        for (int s = 0; s < 2; ++s) {
            const int p = 2 * c + s;
            const float lr = lam_re[pb * SSM_P + p], li = lam_im[pb * SSM_P + p], zr = lr * dt, zi = li * dt;
            const float em1 = expm1f(zr), mag = em1 + 1.0f; float sn, cs, sh, ch; sincos_f(zi, sn, cs); sincos_f(0.5f * zi, sh, ch);
            const float a_r = mag * cs, a_i = mag * sn, am1 = em1 * cs - 2.0f * sh * sh, den = lr * lr + li * li;
            fr[s] = (am1 * lr + a_i * li) / den; fi[s] = (a_i * lr - am1 * li) / den;
            ar[s] = a_r; ai[s] = a_i;
            const float magL = expf(zr * (float)S5_LSEG); sincos_f(zi * (float)S5_LSEG, sn, cs);
            Lr[s] = magL * cs; Li[s] = magL * sn;
        }
        bf16x8 Bf[4];
#pragma unroll
        for (int s = 0; s < 2; ++s) {
            const int p = 2 * c + s;
            const float* pr = b_re + ((size_t)pb * SSM_P + p) * SSM_K + 8 * h; const float* pi = b_im + ((size_t)pb * SSM_P + p) * SSM_K + 8 * h;
            const f32x4 r0 = *(const f32x4*)pr, r1 = *(const f32x4*)(pr + 4), i0 = *(const f32x4*)pi, i1 = *(const f32x4*)(pi + 4);
            float vr[8], vi[8];
#pragma unroll
            for (int j = 0; j < 4; ++j) { vr[j] = fr[s] * r0[j] - fi[s] * i0[j]; vr[4 + j] = fr[s] * r1[j] - fi[s] * i1[j];
                                          vi[j] = fr[s] * i0[j] + fi[s] * r0[j]; vi[4 + j] = fr[s] * i1[j] + fi[s] * r1[j]; }
            u32x4 wr_, wi_; wr_.x = pk2(vr[0], vr[1]); wr_.y = pk2(vr[2], vr[3]); wr_.z = pk2(vr[4], vr[5]); wr_.w = pk2(vr[6], vr[7]);
            wi_.x = pk2(vi[0], vi[1]); wi_.y = pk2(vi[2], vi[3]); wi_.z = pk2(vi[4], vi[5]); wi_.w = pk2(vi[6], vi[7]);
            Bf[s] = __builtin_bit_cast(bf16x8, wr_); Bf[2 + s] = __builtin_bit_cast(bf16x8, wi_);
        }
        bf16x8 Cf[4];
        if (PASS == 2) {
#pragma unroll
            for (int ks = 0; ks < 4; ++ks) {
                const float* src = ((ks >> 1) ? c_im : c_re) + ((size_t)pb * SSM_K + i15) * SSM_P + 32 * (ks & 1) + 8 * kq;
                const float sg = (ks >> 1) ? -1.0f : 1.0f;
                const f32x4 v0 = *(const f32x4*)src * sg, v1 = *(const f32x4*)(src + 4) * sg;
                u32x4 w; w.x = pk2(v0[0], v0[1]); w.y = pk2(v0[2], v0[3]); w.z = pk2(v1[0], v1[1]); w.w = pk2(v1[2], v1[3]);
                Cf[ks] = __builtin_bit_cast(bf16x8, w);
            }
        }
        float sr[2] = {0.f, 0.f}, si[2] = {0.f, 0.f};
        if (PASS == 2) {
            for (int i = 0; i < seg; ++i) {
                const f32x4 e = *(const f32x4*)(E + ((((size_t)(dir * SSM_G + g) * S5_NSEG + i) * 2 + h) * SSM_P + 2 * c) * 2);
                const float n0r = Lr[0] * sr[0] - Li[0] * si[0] + e[0], n0i = Lr[0] * si[0] + Li[0] * sr[0] + e[1];
                const float n1r = Lr[1] * sr[1] - Li[1] * si[1] + e[2], n1i = Lr[1] * si[1] + Li[1] * sr[1] + e[3];
                sr[0] = n0r; si[0] = n0i; sr[1] = n1r; si[1] = n1i;
            }
        }
        const int rr = lane & 31, hrow = (rr >> 2) & 1, tau_a = 4 * (rr >> 3) + (rr & 3);
        const bf16_t* Ucol = U + (size_t)hrow * SEQ * D + 16 * g + 8 * h;
        const int nbase = seg * S5_LSEG;
        bf16_t* Y = dir ? YB : YF;
#define S5_TPOS(n) (dir ? (SEQ - 1 - (n)) : (n))
        constexpr int NW = S5_LSEG / 16, PF = 4;
        bf16x8 Aq[PF];
#pragma unroll
        for (int i = 0; i < PF; ++i) Aq[i] = *(const bf16x8*)(Ucol + (size_t)S5_TPOS(nbase + 16 * i + tau_a) * D);
        for (int w4 = 0; w4 < NW; w4 += PF) {
#pragma unroll
        for (int wi = 0; wi < PF; ++wi) {
            const int w = w4 + wi;
            const bf16x8 Acur = Aq[wi];
            const int wn = (w + PF < NW) ? w + PF : NW - 1;
            Aq[wi] = *(const bf16x8*)(Ucol + (size_t)S5_TPOS(nbase + 16 * wn + tau_a) * D);
            f32x16 acc[4];
#pragma unroll
            for (int nb = 0; nb < 4; ++nb) { f32x16 z;
#pragma unroll
                for (int q = 0; q < 16; ++q) z[q] = 0.f;
                acc[nb] = __builtin_amdgcn_mfma_f32_32x32x16_bf16(Acur, Bf[nb], z, 0, 0, 0); }
#pragma unroll
            for (int tau = 0; tau < 16; ++tau) {
                const float n0r = ar[0] * sr[0] - ai[0] * si[0] + acc[0][tau], n0i = ar[0] * si[0] + ai[0] * sr[0] + acc[2][tau];
                const float n1r = ar[1] * sr[1] - ai[1] * si[1] + acc[1][tau], n1i = ar[1] * si[1] + ai[1] * sr[1] + acc[3][tau];
                sr[0] = n0r; si[0] = n0i; sr[1] = n1r; si[1] = n1i;
                if (PASS == 2) {
                    *(LAS unsigned*)(tile + (16 * h + tau) * TP + 4 * c) = pk2(n0r, n1r);
                    *(LAS unsigned*)(tile + (16 * h + tau) * TP + 128 + 4 * c) = pk2(n0i, n1i);
                }
            }
            if (PASS == 2) {
                LDS_WAIT();
#pragma unroll
                for (int mb = 0; mb < 2; ++mb) {
                    f32x4 y = {0.f, 0.f, 0.f, 0.f};
#pragma unroll
                    for (int ks = 0; ks < 4; ++ks) { const bf16x8 Af = *(const LAS bf16x8*)(tile + (16 * mb + i15) * TP + (32 * ks + 8 * kq) * 2);
                        y = __builtin_amdgcn_mfma_f32_16x16x32_bf16(Cf[ks], Af, y, 0, 0, 0); }
                    { const int t = S5_TPOS(nbase + 16 * w + i15); u32x2 yw; yw.x = pk2(y[0], y[1]); yw.y = pk2(y[2], y[3]);
                      *(u32x2*)(Y + ((size_t)mb * SEQ + t) * D + 16 * g + 4 * kq) = yw; }
                }
            }
        } }
        if (PASS == 1) {
            f32x4 e = {sr[0], si[0], sr[1], si[1]};
            *(f32x4*)(E + ((((size_t)(dir * SSM_G + g) * S5_NSEG + seg) * 2 + h) * SSM_P + 2 * c) * 2) = e;
        }
    }
}
#undef S5_TPOS
__device__ __forceinline__ unsigned lds_addr0(const LAS unsigned char* p) { return (unsigned)(unsigned long long)p; }
__device__ __forceinline__ void s5_pass1(const Frame& F, int jl, const bf16_t* __restrict__ U, const float* __restrict__ lam_re, const float* __restrict__ lam_im, const float* __restrict__ log_dt,
                                         const float* __restrict__ b_re, const float* __restrict__ b_im, float* __restrict__ E) {
    const int tid = F.tid, lane = F.lane, c = lane & 31, h = lane >> 5, w = F.wave;
    constexpr int WP = 528;
    LAS unsigned char* Wt = F.lds;
    for (int pair0 = F.bid; pair0 < SSM_G * 2; pair0 += F.G) {
        const int pair = (F.G == 256) ? ((pair0 & 7) * 32 + (pair0 >> 3)) : pair0;
        const int dir = pair & 1, g = pair >> 1, pb = (jl * 2 + dir) * SSM_G + g;
        const float dt = expf(log_dt[pb]);
        __syncthreads();
        { const int col = tid & 127, tq = tid >> 7, nb = col >> 5, p = 2 * (col & 31) + (nb & 1), part = nb >> 1;
          const float lr = lam_re[pb * SSM_P + p], li = lam_im[pb * SSM_P + p], zr = lr * dt, zi = li * dt;
          const float em1 = expm1f(zr), mag = em1 + 1.0f; float sn, cs, sh, ch; sincos_f(zi, sn, cs); sincos_f(0.5f * zi, sh, ch);
          const float a_i = mag * sn, am1 = em1 * cs - 2.0f * sh * sh, den = lr * lr + li * li;
          const float fr = (am1 * lr + a_i * li) / den, fi = (a_i * lr - am1 * li) / den;
          const float* pr = b_re + ((size_t)pb * SSM_P + p) * SSM_K; const float* pi = b_im + ((size_t)pb * SSM_P + p) * SSM_K;
          f32x4 br[4], bi[4];
#pragma unroll
          for (int q = 0; q < 4; ++q) { br[q] = *(const f32x4*)(pr + 4 * q); bi[q] = *(const f32x4*)(pi + 4 * q); }
#pragma unroll
          for (int tt = 0; tt < 4; ++tt) { const int tau = 4 * tq + tt; const float pw = (float)(15 - tau);
              const float mg = expf(zr * pw); float s2, c2; sincos_f(zi * pw, s2, c2);
              const float pr_ = mg * c2, pi_ = mg * s2, cr = pr_ * fr - pi_ * fi, ci = pr_ * fi + pi_ * fr;
              unsigned wv[8];
#pragma unroll
              for (int q = 0; q < 4; ++q) { float v[4];
#pragma unroll
                  for (int e = 0; e < 4; ++e) v[e] = part ? (cr * bi[q][e] + ci * br[q][e]) : (cr * br[q][e] - ci * bi[q][e]);
                  wv[2 * q] = pk2(v[0], v[1]); wv[2 * q + 1] = pk2(v[2], v[3]); }
              LAS u32x4* dst = (LAS u32x4*)(Wt + col * WP + tau * 32);
              dst[0] = (u32x4){wv[0], wv[1], wv[2], wv[3]}; dst[1] = (u32x4){wv[4], wv[5], wv[6], wv[7]}; } }
        __syncthreads();
        if (w < S5_NSEG - 1) {
            const int seg = w;
            float L16r[2], L16i[2], sr[2] = {0.f, 0.f}, si[2] = {0.f, 0.f};
#pragma unroll
            for (int s = 0; s < 2; ++s) { const int p = 2 * c + s; const float zr = lam_re[pb * SSM_P + p] * dt, zi = lam_im[pb * SSM_P + p] * dt;
                const float mg = expf(16.0f * zr); float sn, cs; sincos_f(16.0f * zi, sn, cs); L16r[s] = mg * cs; L16i[s] = mg * sn; }
            const int rr = lane & 31, hrow = (rr >> 2) & 1, om = 4 * (rr >> 3) + (rr & 3);
            const bf16_t* Ucol = U + (size_t)hrow * SEQ * D + 16 * g + 8 * h;
            for (int wg = 0; wg < S5_LSEG / 256; ++wg) {
                const int n0 = seg * S5_LSEG + (16 * wg + om) * 16;
                f32x16 acc[4];
#pragma unroll
                for (int nb = 0; nb < 4; ++nb)
#pragma unroll
                    for (int q = 0; q < 16; ++q) acc[nb][q] = 0.f;
                unsigned wb = lds_addr0(Wt + c * WP + 16 * h); asm volatile("" : "+v"(wb));
#pragma unroll
                for (int th = 0; th < 2; ++th) {
                    bf16x8 Aq[8];
#pragma unroll
                    for (int t8 = 0; t8 < 8; ++t8) { const int n = n0 + 8 * th + t8, t = dir ? (SEQ - 1 - n) : n; Aq[t8] = *(const bf16x8*)(Ucol + (size_t)t * D); }
#pragma unroll
                    for (int t8 = 0; t8 < 8; ++t8)
#pragma unroll
                        for (int nb = 0; nb < 4; ++nb) { const bf16x8 Bq = *(const LAS bf16x8*)(size_t)(wb + (32 * nb) * WP + (8 * th + t8) * 32);
                            acc[nb] = __builtin_amdgcn_mfma_f32_32x32x16_bf16(Aq[t8], Bq, acc[nb], 0, 0, 0); }
                }
#pragma unroll
                for (int o = 0; o < 16; ++o) {
                    const float n0r = L16r[0] * sr[0] - L16i[0] * si[0] + acc[0][o], n0i = L16r[0] * si[0] + L16i[0] * sr[0] + acc[2][o];
                    const float n1r = L16r[1] * sr[1] - L16i[1] * si[1] + acc[1][o], n1i = L16r[1] * si[1] + L16i[1] * sr[1] + acc[3][o];
                    sr[0] = n0r; si[0] = n0i; sr[1] = n1r; si[1] = n1i; }
            }
            f32x4 e = {sr[0], si[0], sr[1], si[1]};
            *(f32x4*)(E + ((((size_t)(dir * SSM_G + g) * S5_NSEG + seg) * 2 + h) * SSM_P + 2 * c) * 2) = e;
        }
    }
    __syncthreads();
}
__device__ __forceinline__ void s5_post(const Frame& F, const bf16_t* __restrict__ YF, const bf16_t* __restrict__ YB, const bf16_t* __restrict__ U, const float* __restrict__ dv, bf16_t* __restrict__ O) {
    const size_t n8 = (size_t)MTOK * D / 8;
    for (size_t i = (size_t)F.bid * NTHREADS + F.tid; i < n8; i += (size_t)F.G * NTHREADS) {
        const int col = (int)(i % (D / 8)) * 8;
        const u32x4 aw = *(const u32x4*)(YF + i * 8), bw = *(const u32x4*)(YB + i * 8), uw = *(const u32x4*)(U + i * 8);
        const f32x4 d0 = *(const f32x4*)(dv + col), d1 = *(const f32x4*)(dv + col + 4);
        float y[8];
        y[0] = bf_lo(aw.x) + bf_lo(bw.x) + d0[0] * bf_lo(uw.x); y[1] = bf_hi(aw.x) + bf_hi(bw.x) + d0[1] * bf_hi(uw.x); y[2] = bf_lo(aw.y) + bf_lo(bw.y) + d0[2] * bf_lo(uw.y); y[3] = bf_hi(aw.y) + bf_hi(bw.y) + d0[3] * bf_hi(uw.y);
        y[4] = bf_lo(aw.z) + bf_lo(bw.z) + d1[0] * bf_lo(uw.z); y[5] = bf_hi(aw.z) + bf_hi(bw.z) + d1[1] * bf_hi(uw.z); y[6] = bf_lo(aw.w) + bf_lo(bw.w) + d1[2] * bf_lo(uw.w); y[7] = bf_hi(aw.w) + bf_hi(bw.w) + d1[3] * bf_hi(uw.w);
#pragma unroll
        for (int j = 0; j < 8; ++j) { const float z = 0.7978845608028654f * (y[j] + 0.044715f * y[j] * y[j] * y[j]); y[j] = y[j] * __builtin_amdgcn_rcpf(1.0f + __expf(-2.0f * z)); }
        u32x4 o; o.x = pk2(y[0], y[1]); o.y = pk2(y[2], y[3]); o.z = pk2(y[4], y[5]); o.w = pk2(y[6], y[7]);
        *(u32x4*)(O + i * 8) = o;
    }
}
__device__ __forceinline__ bf16x8 tr_read2(unsigned a0, unsigned a1) {
    bf16x4 r0, r1;
    asm volatile("ds_read_b64_tr_b16 %0, %2\n\tds_read_b64_tr_b16 %1, %3\n\ts_waitcnt lgkmcnt(0)" : "=&v"(r0), "=&v"(r1) : "v"(a0), "v"(a1) : "memory");
    bf16x8 o; o[0] = r0[0]; o[1] = r0[1]; o[2] = r0[2]; o[3] = r0[3]; o[4] = r1[0]; o[5] = r1[1]; o[6] = r1[2]; o[7] = r1[3]; return o;
}
__device__ __forceinline__ unsigned lds_addr(const LAS unsigned char* p) { return (unsigned)(unsigned long long)p; }
constexpr int GLA_QP = 528;
constexpr int GLA_AP = 144;
constexpr int GLA_VP = 272;

__device__ __forceinline__ void gla_a(const Frame& F, int jb, const bf16_t* __restrict__ PROJ, const float* __restrict__ w_gate, const float* __restrict__ b_gate,
                                      bf16_t* __restrict__ QD, bf16_t* __restrict__ KL, bf16_t* __restrict__ ATT, float* __restrict__ DEC) {
    LAS float* Gt = (LAS float*)F.lds;
    LAS float* Tt = (LAS float*)(F.lds + 4096);
    LAS float* BLt = (LAS float*)(F.lds + 4096 + 2048);
    LAS unsigned char* QDt = F.lds + 8192;
    LAS unsigned char* KDt = F.lds + 8192 + 64 * GLA_QP;
    constexpr int GLA_BP = 1040;
    LAS unsigned char* Bt = F.lds + 8192 + 128 * GLA_QP;
    const int tid = F.tid, lane = F.lane, w = F.wave, i15 = lane & 15, kq = lane >> 4;
    const int kk = tid & 255, half = tid >> 8;
    for (int item = F.bid; item < 16 * GLA_NCHUNK; item += F.G) {
        const int c = item & (GLA_NCHUNK - 1), seq = item >> 8, dir = seq & 1, hh = (seq >> 1) & 3, b = seq >> 3;
        const int n0 = GLA_C * c;
        u32x4 rq[4], rk[4];
#pragma unroll
        for (int i = 0; i < 4; ++i) { const int q_ = tid + 512 * i, n = q_ >> 5, ch = q_ & 31, nn = n0 + n, t = dir ? (SEQ - 1 - nn) : nn;
            const bf16_t* rowp = PROJ + (size_t)(b * SEQ + t) * GLA_NPAD + GLA_DKH * hh + 8 * ch; rq[i] = *(const u32x4*)rowp; rk[i] = *(const u32x4*)(rowp + GLA_DK); }
        __syncthreads();
        if (tid < 128) { const int n = tid >> 1, h8 = tid & 1, nn = n0 + n, t = dir ? (SEQ - 1 - nn) : nn;
            const u32x4 wv = *(const u32x4*)(PROJ + (size_t)(b * SEQ + t) * GLA_NPAD + 6144 + 16 * dir + 8 * h8);
            LAS float* gp = Gt + n * 16 + 8 * h8;
            gp[0] = bf_lo(wv.x); gp[1] = bf_hi(wv.x); gp[2] = bf_lo(wv.y); gp[3] = bf_hi(wv.y); gp[4] = bf_lo(wv.z); gp[5] = bf_hi(wv.z); gp[6] = bf_lo(wv.w); gp[7] = bf_hi(wv.w); }
        float wg[16];
#pragma unroll
        for (int r = 0; r < 16; ++r) wg[r] = w_gate[((size_t)(jb * 2 + dir) * GLA_RANK + r) * GLA_DK + GLA_DKH * hh + kk];
        const float bias = b_gate[(size_t)(jb * 2 + dir) * GLA_DK + GLA_DKH * hh + kk];
        __syncthreads();
        float bc[32]; float run = 0.f;
#pragma unroll
        for (int i = 0; i < 32; ++i) { const LAS f32x4* gr = (const LAS f32x4*)(Gt + (32 * half + i) * 16);
            const f32x4 g0 = gr[0], g1 = gr[1], g2 = gr[2], g3 = gr[3];
            float gl = bias;
#pragma unroll
            for (int r = 0; r < 4; ++r) gl += g0[r] * wg[r] + g1[r] * wg[4 + r] + g2[r] * wg[8 + r] + g3[r] * wg[12 + r];
            const float ls = fminf(gl, 0.f) - __logf(1.0f + __expf(-fabsf(gl)));
            run += ls * (1.0f / 16.0f); bc[i] = run; }
        Tt[half * 256 + kk] = run;
        __syncthreads();
        const float t0 = Tt[kk], blast = t0 + Tt[256 + kk];
        if (half) {
#pragma unroll
            for (int i = 0; i < 32; ++i) bc[i] += t0; }
#pragma unroll
        for (int i = 0; i < 32; ++i) *(LAS float*)(Bt + (32 * half + i) * GLA_BP + kk * 4) = bc[i];
        if (half == 0) { BLt[kk] = blast; DEC[((size_t)seq * GLA_NCHUNK + c) * GLA_DKH + kk] = __expf(blast); }
        __syncthreads();
        const size_t grow = (size_t)seq * SEQ + n0;
#pragma unroll
        for (int i = 0; i < 4; ++i) { const int q_ = tid + 512 * i, n = q_ >> 5, ch = q_ & 31;
            const f32x4 b0 = *(const LAS f32x4*)(Bt + n * GLA_BP + ch * 32), b1 = *(const LAS f32x4*)(Bt + n * GLA_BP + ch * 32 + 16);
            const f32x4 l0 = *(const LAS f32x4*)(BLt + 8 * ch), l1 = *(const LAS f32x4*)(BLt + 8 * ch + 4);
            const unsigned qw[4] = {rq[i].x, rq[i].y, rq[i].z, rq[i].w}, kw[4] = {rk[i].x, rk[i].y, rk[i].z, rk[i].w};
            unsigned oq[4], okd[4], okl[4];
#pragma unroll
            for (int e = 0; e < 4; ++e) { const float ba = e < 2 ? b0[2 * e] : b1[2 * e - 4], bb = e < 2 ? b0[2 * e + 1] : b1[2 * e - 3], la = e < 2 ? l0[2 * e] : l1[2 * e - 4], lb = e < 2 ? l0[2 * e + 1] : l1[2 * e - 3];
                const float qa = bf_lo(qw[e]), qb = bf_hi(qw[e]), ka = bf_lo(kw[e]), kb = bf_hi(kw[e]);
                oq[e] = pk2(qa * 0.0625f * __expf(ba), qb * 0.0625f * __expf(bb)); okd[e] = pk2(ka * __expf(-ba), kb * __expf(-bb)); okl[e] = pk2(ka * __expf(la - ba), kb * __expf(lb - bb)); }
            const u32x4 vq = {oq[0], oq[1], oq[2], oq[3]}, vkd = {okd[0], okd[1], okd[2], okd[3]}, vkl = {okl[0], okl[1], okl[2], okl[3]};
            *(LAS u32x4*)(QDt + n * GLA_QP + ch * 16) = vq; *(LAS u32x4*)(KDt + n * GLA_QP + ch * 16) = vkd;
            *(u32x4*)(QD + (grow + n) * GLA_DKH + 8 * ch) = vq; *(u32x4*)(KL + (grow + n) * GLA_DKH + 8 * ch) = vkl; }
        __syncthreads();
        const int sb = w >> 1;
        f32x4 acc[2] = {{0.f, 0.f, 0.f, 0.f}, {0.f, 0.f, 0.f, 0.f}};
#pragma unroll
        for (int ks = 0; ks < 8; ++ks) { const bf16x8 Af = *(const LAS bf16x8*)(KDt + (16 * sb + i15) * GLA_QP + (32 * ks + 8 * kq) * 2);
#pragma unroll
            for (int j = 0; j < 2; ++j) { const int nb = 2 * (w & 1) + j; const bf16x8 Bq = *(const LAS bf16x8*)(QDt + (16 * nb + i15) * GLA_QP + (32 * ks + 8 * kq) * 2);
                acc[j] = __builtin_amdgcn_mfma_f32_16x16x32_bf16(Af, Bq, acc[j], 0, 0, 0); } }
#pragma unroll
        for (int j = 0; j < 2; ++j) { const int n = 16 * (2 * (w & 1) + j) + i15, s0 = 16 * sb + 4 * kq;
            float v[4];
#pragma unroll
            for (int e = 0; e < 4; ++e) { const int s = s0 + e; const bool keep = dir ? (s < n) : (s <= n); v[e] = keep ? acc[j][e] : 0.f; }
            u32x2 o; o.x = pk2(v[0], v[1]); o.y = pk2(v[2], v[3]);
            *(u32x2*)(ATT + ((size_t)item * GLA_C + n) * GLA_C + s0) = o; }
    }
    __syncthreads();
}

constexpr int GLA_NSEG = 4, GLA_SEGC = GLA_NCHUNK / GLA_NSEG;
#define TR_ISSUE(r0, r1, a0, a1) asm volatile("ds_read_b64_tr_b16 %0, %2\n\tds_read_b64_tr_b16 %1, %3" : "=&v"(r0), "=&v"(r1) : "v"(a0), "v"(a1) : "memory")
__device__ __forceinline__ bf16x8 tr_join(bf16x4 r0, bf16x4 r1) { bf16x8 o; o[0] = r0[0]; o[1] = r0[1]; o[2] = r0[2]; o[3] = r0[3]; o[4] = r1[0]; o[5] = r1[1]; o[6] = r1[2]; o[7] = r1[3]; return o; }
template <int PASS>
__device__ __forceinline__ void gla_b(const Frame& F, const bf16_t* __restrict__ PROJ, const bf16_t* __restrict__ QD, const bf16_t* __restrict__ KL, const bf16_t* __restrict__ ATT,
                                      const float* __restrict__ DEC, bf16_t* __restrict__ OD, float* __restrict__ SLOC) {
    const int s64 = ((F.bid >> 5) << 3) + (F.bid & 7), seg = s64 & 3;
    if (F.bid >= 256 || (PASS == 1 && seg == GLA_NSEG - 1)) return;
    LAS unsigned char* QDt = F.lds;
    LAS unsigned char* KLt = F.lds + 64 * GLA_QP;
    LAS unsigned char* ATt = F.lds + 128 * GLA_QP;
    LAS unsigned char* Vt = ATt + 64 * GLA_AP;
    LAS unsigned char* DCt = Vt + 64 * GLA_VP;
    const int tid = F.tid, lane = F.lane, w = F.wave, i15 = lane & 15, kq = lane >> 4, qq = (lane & 15) >> 2, p = lane & 3;
    const int qv = (F.bid >> 3) & 3, seq = s64 >> 2, dir = seq & 1, hh = (seq >> 1) & 3, b = seq >> 3;
    f32x4* sl = (f32x4*)SLOC + ((((size_t)(seq * GLA_NSEG + seg) * 4 + qv) * NWAVES + w) * 32) * 64 + lane;
    f32x4 S[16];
#pragma unroll
    for (int i = 0; i < 16; ++i) S[i] = (f32x4){0.f, 0.f, 0.f, 0.f};
    f32x4 Pd[PASS == 1 ? 16 : 1];
    if (PASS == 1) {
#pragma unroll
        for (int i = 0; i < 16; ++i) Pd[i] = (f32x4){1.f, 1.f, 1.f, 1.f};
    } else {
        for (int j = 0; j < seg; ++j) { const f32x4* sj = (const f32x4*)SLOC + ((((size_t)(seq * GLA_NSEG + j) * 4 + qv) * NWAVES + w) * 32) * 64 + lane;
#pragma unroll
            for (int i = 0; i < 16; ++i) S[i] = sj[(16 + i) * 64] * S[i] + sj[i * 64]; }
    }
    u32x4 rq[PASS == 2 ? 4 : 1], rk[4], ra, rv[2]; f32x4 rd = {0.f, 0.f, 0.f, 0.f};
#define GLA_B_LOAD(cc) do { \
        const u32x4* ksrc = (const u32x4*)(KL + ((size_t)seq * SEQ + (size_t)GLA_C * (cc)) * GLA_DKH); \
        _Pragma("unroll") for (int i = 0; i < 4; ++i) rk[i] = ksrc[tid + 512 * i]; \
        if (PASS == 2) { const u32x4* qsrc = (const u32x4*)(QD + ((size_t)seq * SEQ + (size_t)GLA_C * (cc)) * GLA_DKH); \
            _Pragma("unroll") for (int i = 0; i < 4; ++i) rq[i] = qsrc[tid + 512 * i]; \
            ra = ((const u32x4*)(ATT + ((size_t)seq * GLA_NCHUNK + (cc)) * (GLA_C * GLA_C)))[tid]; } \
        _Pragma("unroll") for (int i = 0; i < 2; ++i) { const int q_ = tid + 512 * i, n_ = q_ >> 4, ch_ = q_ & 15, nn_ = GLA_C * (cc) + n_, t_ = dir ? (SEQ - 1 - nn_) : nn_; \
            rv[i] = *(const u32x4*)(PROJ + (size_t)(b * SEQ + t_) * GLA_NPAD + 2048 + GLA_DVH * hh + 128 * qv + 8 * ch_); } \
        if (tid < 64) rd = *(const f32x4*)(DEC + ((size_t)seq * GLA_NCHUNK + (cc)) * GLA_DKH + 4 * tid); } while (0)
    const int c0 = seg * GLA_SEGC;
    GLA_B_LOAD(c0);
    for (int c = c0; c < c0 + GLA_SEGC; ++c) {
        __syncthreads();
#pragma unroll
        for (int i = 0; i < 4; ++i) { const int q_ = tid + 512 * i, row = q_ >> 5, ch = q_ & 31;
            if (PASS == 2) *(LAS u32x4*)(QDt + row * GLA_QP + ch * 16) = rq[i];
            *(LAS u32x4*)(KLt + row * GLA_QP + ch * 16) = rk[i]; }
        if (PASS == 2) *(LAS u32x4*)(ATt + (tid >> 3) * GLA_AP + (tid & 7) * 16) = ra;
#pragma unroll
        for (int i = 0; i < 2; ++i) { const int q_ = tid + 512 * i; *(LAS u32x4*)(Vt + (q_ >> 4) * GLA_VP + (q_ & 15) * 16) = rv[i]; }
        if (tid < 64) *(LAS f32x4*)(DCt + 16 * tid) = rd;
        __syncthreads();
        if (c + 1 < c0 + GLA_SEGC) GLA_B_LOAD(c + 1);
        unsigned vtb = lds_addr(Vt + (8 * kq + qq) * GLA_VP + (16 * w + 4 * p) * 2), klb = lds_addr(KLt + (8 * kq + qq) * GLA_QP + (4 * p) * 2);
        asm volatile("" : "+v"(vtb), "+v"(klb));
        bf16x8 Vf[2];
        { bf16x4 t0, t1, t2, t3; const unsigned a0 = vtb, a1 = vtb + 4 * GLA_VP, a2 = vtb + 32 * GLA_VP, a3 = vtb + 36 * GLA_VP;
          asm volatile("ds_read_b64_tr_b16 %0, %4\n\tds_read_b64_tr_b16 %1, %5\n\tds_read_b64_tr_b16 %2, %6\n\tds_read_b64_tr_b16 %3, %7\n\ts_waitcnt lgkmcnt(0)"
                       : "=&v"(t0), "=&v"(t1), "=&v"(t2), "=&v"(t3) : "v"(a0), "v"(a1), "v"(a2), "v"(a3) : "memory");
          Vf[0] = tr_join(t0, t1); Vf[1] = tr_join(t2, t3); }
        if (PASS == 2) {
            f32x4 o[4];
#pragma unroll
            for (int rb = 0; rb < 4; ++rb) { o[rb] = (f32x4){0.f, 0.f, 0.f, 0.f};
#pragma unroll
                for (int ks = 0; ks < 2; ++ks) { const bf16x8 Af = *(const LAS bf16x8*)(ATt + (16 * rb + i15) * GLA_AP + (32 * ks + 8 * kq) * 2);
                    o[rb] = __builtin_amdgcn_mfma_f32_16x16x32_bf16(Vf[ks], Af, o[rb], 0, 0, 0); } }
#pragma unroll
            for (int kb2 = 0; kb2 < 8; ++kb2) {
                u32x4 bw; bw.x = pk2(S[2 * kb2][0], S[2 * kb2][1]); bw.y = pk2(S[2 * kb2][2], S[2 * kb2][3]); bw.z = pk2(S[2 * kb2 + 1][0], S[2 * kb2 + 1][1]); bw.w = pk2(S[2 * kb2 + 1][2], S[2 * kb2 + 1][3]);
                const bf16x8 Bs = __builtin_bit_cast(bf16x8, bw);
#pragma unroll
                for (int rb = 0; rb < 4; ++rb) { const LAS unsigned char* ap = QDt + (16 * rb + i15) * GLA_QP + (32 * kb2 + 4 * kq) * 2;
                    const u32x2 lo = *(const LAS u32x2*)ap, hi = *(const LAS u32x2*)(ap + 32);
                    u32x4 aw; aw.x = lo.x; aw.y = lo.y; aw.z = hi.x; aw.w = hi.y;
                    o[rb] = __builtin_amdgcn_mfma_f32_16x16x32_bf16(Bs, __builtin_bit_cast(bf16x8, aw), o[rb], 0, 0, 0); } }
#pragma unroll
            for (int rb = 0; rb < 4; ++rb) { const int nn = GLA_C * c + 16 * rb + i15, t = dir ? (SEQ - 1 - nn) : nn;
                u32x2 ow; ow.x = pk2(o[rb][0], o[rb][1]); ow.y = pk2(o[rb][2], o[rb][3]);
                *(u32x2*)(OD + ((size_t)dir * MTOK + (size_t)b * SEQ + t) * GLA_DV + GLA_DVH * hh + 128 * qv + 16 * w + 4 * kq) = ow; }
        }
#pragma unroll
        for (int kb = 0; kb < 16; kb += 2) {
            bf16x4 t0, t1, t2, t3, t4, t5, t6, t7;
            const unsigned b0 = klb + (16 * kb) * 2, b1 = b0 + 32 * GLA_QP, b2 = b0 + 32, b3 = b2 + 32 * GLA_QP;
            const f32x4 d0 = *(const LAS f32x4*)(DCt + (16 * kb + 4 * kq) * 4), d1 = *(const LAS f32x4*)(DCt + (16 * (kb + 1) + 4 * kq) * 4);
            asm volatile("ds_read_b64_tr_b16 %0, %8\n\tds_read_b64_tr_b16 %1, %8 offset:2112\n\tds_read_b64_tr_b16 %2, %9\n\tds_read_b64_tr_b16 %3, %9 offset:2112\n\t"
                         "ds_read_b64_tr_b16 %4, %10\n\tds_read_b64_tr_b16 %5, %10 offset:2112\n\tds_read_b64_tr_b16 %6, %11\n\tds_read_b64_tr_b16 %7, %11 offset:2112\n\ts_waitcnt lgkmcnt(0)"
                         : "=&v"(t0), "=&v"(t1), "=&v"(t2), "=&v"(t3), "=&v"(t4), "=&v"(t5), "=&v"(t6), "=&v"(t7) : "v"(b0), "v"(b1), "v"(b2), "v"(b3) : "memory");
            static_assert(4 * GLA_QP == 2112, "offset literal in the asm above");
            S[kb] = S[kb] * d0; S[kb + 1] = S[kb + 1] * d1;
            if (PASS == 1) { Pd[kb] = Pd[kb] * d0; Pd[kb + 1] = Pd[kb + 1] * d1; }
            S[kb] = __builtin_amdgcn_mfma_f32_16x16x32_bf16(tr_join(t0, t1), Vf[0], S[kb], 0, 0, 0); S[kb] = __builtin_amdgcn_mfma_f32_16x16x32_bf16(tr_join(t2, t3), Vf[1], S[kb], 0, 0, 0);
            S[kb + 1] = __builtin_amdgcn_mfma_f32_16x16x32_bf16(tr_join(t4, t5), Vf[0], S[kb + 1], 0, 0, 0); S[kb + 1] = __builtin_amdgcn_mfma_f32_16x16x32_bf16(tr_join(t6, t7), Vf[1], S[kb + 1], 0, 0, 0);
        }
    }
    if (PASS == 1) {
#pragma unroll
        for (int i = 0; i < 16; ++i) { sl[i * 64] = S[i]; sl[(16 + i) * 64] = Pd[i]; }
    }
#undef GLA_B_LOAD
}

__device__ __forceinline__ void gla_c(const Frame& F, const bf16_t* __restrict__ PROJ, const bf16_t* __restrict__ OD, const float* __restrict__ ng, bf16_t* __restrict__ O) {
    const int gw = F.bid * NWAVES + F.wave, NGW = F.G * NWAVES, lane = F.lane;
    for (int row = gw; row < MTOK; row += NGW) {
        const u32x4* pf = (const u32x4*)(OD + (size_t)row * GLA_DV) + lane; const u32x4* pb = (const u32x4*)(OD + ((size_t)MTOK + row) * GLA_DV) + lane;
        const u32x4* pr = (const u32x4*)(PROJ + (size_t)row * GLA_NPAD + 4096) + lane;
        u32x4 a[4], bq[4], rw[4];
#pragma unroll
        for (int j = 0; j < 4; ++j) { a[j] = pf[64 * j]; bq[j] = pb[64 * j]; rw[j] = pr[64 * j]; }
        u32x4* po = (u32x4*)(O + (size_t)row * GLA_DV) + lane;
#pragma unroll
        for (int j = 0; j < 4; ++j) {
            float v[8];
            v[0] = bf_lo(a[j].x) + bf_lo(bq[j].x); v[1] = bf_hi(a[j].x) + bf_hi(bq[j].x); v[2] = bf_lo(a[j].y) + bf_lo(bq[j].y); v[3] = bf_hi(a[j].y) + bf_hi(bq[j].y);
            v[4] = bf_lo(a[j].z) + bf_lo(bq[j].z); v[5] = bf_hi(a[j].z) + bf_hi(bq[j].z); v[6] = bf_lo(a[j].w) + bf_lo(bq[j].w); v[7] = bf_hi(a[j].w) + bf_hi(bq[j].w);
            float ss = 0.f;
#pragma unroll
            for (int e = 0; e < 8; ++e) ss += v[e] * v[e];
            const float rstd = 1.0f / sqrtf(wave_sum(ss, lane) * (1.0f / GLA_DVH) + 1e-6f);
            const f32x4 g0 = *(const f32x4*)(ng + 8 * (lane + 64 * j)), g1 = *(const f32x4*)(ng + 8 * (lane + 64 * j) + 4);
            const float r[8] = {bf_lo(rw[j].x), bf_hi(rw[j].x), bf_lo(rw[j].y), bf_hi(rw[j].y), bf_lo(rw[j].z), bf_hi(rw[j].z), bf_lo(rw[j].w), bf_hi(rw[j].w)};
            float y[8];
#pragma unroll
            for (int e = 0; e < 8; ++e) { const float gg = e < 4 ? g0[e] : g1[e - 4]; y[e] = v[e] * rstd * gg * (r[e] * __builtin_amdgcn_rcpf(1.0f + __expf(-r[e]))); }
            u32x4 ow; ow.x = pk2(y[0], y[1]); ow.y = pk2(y[2], y[3]); ow.z = pk2(y[4], y[5]); ow.w = pk2(y[6], y[7]); po[64 * j] = ow; }
    }
}
__device__ __forceinline__ void dsa_norm(const Frame& F, bf16_t* __restrict__ QKV, const float* __restrict__ qn, const float* __restrict__ kn, const float* __restrict__ COS, const float* __restrict__ SIN) {
    const int gw = F.bid * NWAVES + F.wave, NGW = F.G * NWAVES, lane = F.lane, j = lane & 7;
    for (int row = gw; row < MTOK; row += NGW) {
        const int pos = row & (SEQ - 1);
        bf16_t* rp = QKV + (size_t)row * DSA_QKV + (lane >> 3) * DSA_HD + 8 * j;
        u32x4 w1[6], w2[6];
#pragma unroll
        for (int k = 0; k < 6; ++k) { w1[k] = *(const u32x4*)(rp + 8 * k * DSA_HD); w2[k] = *(const u32x4*)(rp + 8 * k * DSA_HD + 64); }
        const f32x4 c0 = *(const f32x4*)(COS + pos * 64 + 8 * j), c1 = *(const f32x4*)(COS + pos * 64 + 8 * j + 4), s0 = *(const f32x4*)(SIN + pos * 64 + 8 * j), s1 = *(const f32x4*)(SIN + pos * 64 + 8 * j + 4);
        const float cs[8] = {c0[0], c0[1], c0[2], c0[3], c1[0], c1[1], c1[2], c1[3]}, sn[8] = {s0[0], s0[1], s0[2], s0[3], s1[0], s1[1], s1[2], s1[3]};
#pragma unroll
        for (int k = 0; k < 6; ++k) {
            const float* gn = (k < 3 ? qn : kn) + (k % 3) * DSA_HD + 8 * j;
            const f32x4 g10 = *(const f32x4*)gn, g11 = *(const f32x4*)(gn + 4), g20 = *(const f32x4*)(gn + 64), g21 = *(const f32x4*)(gn + 68);
            const float g1[8] = {g10[0], g10[1], g10[2], g10[3], g11[0], g11[1], g11[2], g11[3]}, g2[8] = {g20[0], g20[1], g20[2], g20[3], g21[0], g21[1], g21[2], g21[3]};
            const unsigned a[4] = {w1[k].x, w1[k].y, w1[k].z, w1[k].w}, b[4] = {w2[k].x, w2[k].y, w2[k].z, w2[k].w};
            float x1[8], x2[8]; float ss = 0.f;
#pragma unroll
            for (int e = 0; e < 4; ++e) { x1[2 * e] = bf_lo(a[e]); x1[2 * e + 1] = bf_hi(a[e]); x2[2 * e] = bf_lo(b[e]); x2[2 * e + 1] = bf_hi(b[e]); }
#pragma unroll
            for (int e = 0; e < 8; ++e) ss += x1[e] * x1[e] + x2[e] * x2[e];
            ss += shx(ss, 1, lane); ss += shx(ss, 2, lane); ss += shx(ss, 4, lane);
            const float rstd = 1.0f / sqrtf(ss * (1.0f / DSA_HD) + 1e-6f), sc = (k < 3) ? 0.08838834764831845f : 1.0f;
            unsigned o1[4], o2[4];
#pragma unroll
            for (int e = 0; e < 4; ++e) { float r1[2], r2[2];
#pragma unroll
                for (int u = 0; u < 2; ++u) { const int i = 2 * e + u; const float y1 = x1[i] * rstd * g1[i], y2 = x2[i] * rstd * g2[i];
                    r1[u] = (y1 * cs[i] - y2 * sn[i]) * sc; r2[u] = (y2 * cs[i] + y1 * sn[i]) * sc; }
                o1[e] = pk2(r1[0], r1[1]); o2[e] = pk2(r2[0], r2[1]); }
            *(u32x4*)(rp + 8 * k * DSA_HD) = (u32x4){o1[0], o1[1], o1[2], o1[3]}; *(u32x4*)(rp + 8 * k * DSA_HD + 64) = (u32x4){o2[0], o2[1], o2[2], o2[3]};
        }
    }
}
constexpr int DSA_TP = 272, DSA_TROWS = 272;
struct DsaItem { int qbr, hd, g, b, dil, Ls, r, qb, i0, qcol; };
__device__ __forceinline__ DsaItem dsa_decode(int item0) {
    const int item = (item0 & ~255) + ((item0 & 7) * 32 + ((item0 & 255) >> 3));
    DsaItem d; d.qbr = item & 127; d.hd = (item >> 7) & 7; d.g = (item >> 10) % 3; d.b = item / 3072;
    d.dil = (d.g == 0) ? 1 : (d.g == 1) ? 4 : 16; d.Ls = SEQ / d.dil; const int nqb = d.Ls / 128; d.r = d.qbr / nqb; d.qb = d.qbr % nqb;
    d.i0 = 128 * d.qb - 64; d.qcol = (d.g * 8 + d.hd) * DSA_HD; return d;
}
__device__ __forceinline__ void dsa_attn(const Frame& F, const bf16_t* __restrict__ QKV, float* __restrict__ PO, float* __restrict__ LSE) {
    LAS unsigned char* Kt = F.lds;
    LAS unsigned char* Vt = F.lds + DSA_TROWS * DSA_TP;
    const int tid = F.tid, lane = F.lane, w = F.wave, i15 = lane & 15, kq = lane >> 4, qq = (lane & 15) >> 2, p = lane & 3;
    constexpr int NITEM = BATCH * DSA_G * DSA_H * 128;
    if (tid < 272) { const u32x4 z = {0u, 0u, 0u, 0u}; *(LAS u32x4*)(Kt + 256 * DSA_TP + 16 * tid) = z; *(LAS u32x4*)(Vt + 256 * DSA_TP + 16 * tid) = z; }
    u32x4 rk[8], rv[8]; bf16x8 Qn[4];
#define DSA_LOAD(it_) do { const DsaItem d_ = dsa_decode(it_); const bf16_t* Bb_ = QKV + (size_t)d_.b * SEQ * DSA_QKV; \
        _Pragma("unroll") for (int k8 = 0; k8 < 8; ++k8) { const int q_ = tid + 512 * k8, jj = q_ >> 4, ch = q_ & 15, i = d_.i0 + jj; const bool valid = (i >= 0) && (i < d_.Ls); \
            rk[k8] = (u32x4){0u, 0u, 0u, 0u}; rv[k8] = (u32x4){0u, 0u, 0u, 0u}; \
            if (valid) { const bf16_t* src = Bb_ + (size_t)(d_.r + d_.dil * i) * DSA_QKV + d_.qcol + 8 * ch; rk[k8] = *(const u32x4*)(src + 3072); rv[k8] = *(const u32x4*)(src + 6144); } } \
        const int qpos_ = d_.r + d_.dil * (128 * d_.qb + 16 * w + i15); \
        _Pragma("unroll") for (int ks = 0; ks < 4; ++ks) Qn[ks] = *(const bf16x8*)(Bb_ + (size_t)qpos_ * DSA_QKV + d_.qcol + 32 * ks + 8 * kq); } while (0)
    if (F.bid < NITEM) DSA_LOAD(F.bid);
    for (int item = F.bid; item < NITEM; item += F.G) {
        const DsaItem d = dsa_decode(item);
        const int i0 = d.i0, Ls = d.Ls;
        const int qi = 128 * d.qb + 16 * w + i15, qpos = d.r + d.dil * qi;
        __syncthreads();
#pragma unroll
        for (int k8 = 0; k8 < 8; ++k8) { const int q_ = tid + 512 * k8, jj = q_ >> 4, ch = q_ & 15;
            *(LAS u32x4*)(Kt + jj * DSA_TP + 16 * ch) = rk[k8]; *(LAS u32x4*)(Vt + jj * DSA_TP + 16 * ch) = rv[k8]; }
        bf16x8 Qf[4];
#pragma unroll
        for (int ks = 0; ks < 4; ++ks) Qf[ks] = Qn[ks];
        __syncthreads();
        if (item + F.G < NITEM) DSA_LOAD(item + F.G);
        f32x4 sa[10];
#pragma unroll
        for (int cb = 0; cb < 10; ++cb) { sa[cb] = (f32x4){0.f, 0.f, 0.f, 0.f};
#pragma unroll
            for (int ks = 0; ks < 4; ++ks) { const bf16x8 Af = *(const LAS bf16x8*)(Kt + (16 * (w + cb) + i15) * DSA_TP + (32 * ks + 8 * kq) * 2);
                sa[cb] = __builtin_amdgcn_mfma_f32_16x16x32_bf16(Af, Qf[ks], sa[cb], 0, 0, 0); } }
        float m = -1e30f;
#pragma unroll
        for (int cb = 0; cb < 10; ++cb)
#pragma unroll
            for (int e = 0; e < 4; ++e) { const int jrel = 16 * cb + 4 * kq + e - i15, ki = i0 + 16 * (w + cb) + 4 * kq + e;
                const bool ok = (jrel >= 0) && (jrel <= 128) && (ki >= 0) && (ki < Ls);
                sa[cb][e] = ok ? sa[cb][e] : -1e30f; m = fmaxf(m, sa[cb][e]); }
        m = fmaxf(m, shx(m, 16, lane)); m = fmaxf(m, shx(m, 32, lane));
        float l = 0.f;
#pragma unroll
        for (int cb = 0; cb < 10; ++cb)
#pragma unroll
            for (int e = 0; e < 4; ++e) { const float pe = __expf(sa[cb][e] - m); sa[cb][e] = pe; l += pe; }
        l += shx(l, 16, lane); l += shx(l, 32, lane);
        f32x4 oa[8];
#pragma unroll
        for (int db = 0; db < 8; ++db) oa[db] = (f32x4){0.f, 0.f, 0.f, 0.f};
        unsigned vtb = lds_addr(Vt + (16 * w + 4 * kq + qq) * DSA_TP + (4 * p) * 2); asm volatile("" : "+v"(vtb));
#pragma unroll
        for (int s5 = 0; s5 < 5; ++s5) {
            u32x4 pw; pw.x = pk2(sa[2 * s5][0], sa[2 * s5][1]); pw.y = pk2(sa[2 * s5][2], sa[2 * s5][3]); pw.z = pk2(sa[2 * s5 + 1][0], sa[2 * s5 + 1][1]); pw.w = pk2(sa[2 * s5 + 1][2], sa[2 * s5 + 1][3]);
            const bf16x8 Pf = __builtin_bit_cast(bf16x8, pw);
#pragma unroll
            for (int dq = 0; dq < 2; ++dq) {
                bf16x4 t0, t1, t2, t3, t4, t5, t6, t7;
                const unsigned a0 = vtb + (32 * s5) * DSA_TP + (64 * dq) * 2, a1 = a0 + 16 * DSA_TP;
                asm volatile("ds_read_b64_tr_b16 %0, %8\n\tds_read_b64_tr_b16 %1, %9\n\tds_read_b64_tr_b16 %2, %8 offset:32\n\tds_read_b64_tr_b16 %3, %9 offset:32\n\t"
                             "ds_read_b64_tr_b16 %4, %8 offset:64\n\tds_read_b64_tr_b16 %5, %9 offset:64\n\tds_read_b64_tr_b16 %6, %8 offset:96\n\tds_read_b64_tr_b16 %7, %9 offset:96\n\ts_waitcnt lgkmcnt(0)"
                             : "=&v"(t0), "=&v"(t1), "=&v"(t2), "=&v"(t3), "=&v"(t4), "=&v"(t5), "=&v"(t6), "=&v"(t7) : "v"(a0), "v"(a1) : "memory");
                oa[4 * dq + 0] = __builtin_amdgcn_mfma_f32_16x16x32_bf16(tr_join(t0, t1), Pf, oa[4 * dq + 0], 0, 0, 0);
                oa[4 * dq + 1] = __builtin_amdgcn_mfma_f32_16x16x32_bf16(tr_join(t2, t3), Pf, oa[4 * dq + 1], 0, 0, 0);
                oa[4 * dq + 2] = __builtin_amdgcn_mfma_f32_16x16x32_bf16(tr_join(t4, t5), Pf, oa[4 * dq + 2], 0, 0, 0);
                oa[4 * dq + 3] = __builtin_amdgcn_mfma_f32_16x16x32_bf16(tr_join(t6, t7), Pf, oa[4 * dq + 3], 0, 0, 0);
            } }
        const float inv = 1.0f / l;
        float* orow = PO + ((size_t)d.g * MTOK + (size_t)d.b * SEQ + qpos) * DSA_OUT + d.hd * DSA_HD + 4 * kq;
#pragma unroll
        for (int db = 0; db < 8; ++db) *(f32x4*)(orow + 16 * db) = oa[db] * inv;
        if (kq == 0) LSE[(((size_t)d.g * BATCH + d.b) * DSA_H + d.hd) * SEQ + (size_t)d.r * Ls + qi] = m + __logf(l);
    }
#undef DSA_LOAD
    __syncthreads();
}
__device__ __forceinline__ void dsa_merge(const Frame& F, const float* __restrict__ PO, const float* __restrict__ LSE, bf16_t* __restrict__ O) {
    const size_t n8 = (size_t)MTOK * DSA_OUT / 8;
    for (size_t i = (size_t)F.bid * NTHREADS + F.tid; i < n8; i += (size_t)F.G * NTHREADS) {
        const size_t row = i >> 7; const int hd = (int)(i & 127) >> 4;
        const int bb = (int)(row >> 14), pos = (int)(row & (SEQ - 1));
        const float l0 = LSE[(((size_t)0 * BATCH + bb) * DSA_H + hd) * SEQ + pos];
        const float l1 = LSE[(((size_t)1 * BATCH + bb) * DSA_H + hd) * SEQ + (size_t)(pos & 3) * (SEQ / 4) + (pos >> 2)];
        const float l2 = LSE[(((size_t)2 * BATCH + bb) * DSA_H + hd) * SEQ + (size_t)(pos & 15) * (SEQ / 16) + (pos >> 4)];
        const float mx = fmaxf(l0, fmaxf(l1, l2));
        float w0 = __expf(l0 - mx), w1 = __expf(l1 - mx), w2 = __expf(l2 - mx); const float inv = 1.0f / (w0 + w1 + w2); w0 *= inv; w1 *= inv; w2 *= inv;
        const f32x4* p0 = (const f32x4*)(PO + i * 8); const f32x4* p1 = (const f32x4*)(PO + (size_t)MTOK * DSA_OUT + i * 8); const f32x4* p2 = (const f32x4*)(PO + (size_t)2 * MTOK * DSA_OUT + i * 8);
        const f32x4 a = p0[0] * w0 + p1[0] * w1 + p2[0] * w2, bq = p0[1] * w0 + p1[1] * w1 + p2[1] * w2;
        u32x4 o; o.x = pk2(a[0], a[1]); o.y = pk2(a[2], a[3]); o.z = pk2(bq[0], bq[1]); o.w = pk2(bq[2], bq[3]);
        *(u32x4*)(O + i * 8) = o;
    }
}
#ifndef MK_PER_PHASE
#define MK_PER_PHASE 0
#endif
constexpr int N_PHASES = DEPTH * 13;
#ifndef XCC_VB
#define XCC_VB 1
#endif
#ifndef WGM_SWIGLU
#define WGM_SWIGLU 4
#endif
#ifndef WGM_BF16
#define WGM_BF16 4
#endif
#ifndef WGM_RES
#define WGM_RES 4
#endif
#ifndef WGM_GLU
#define WGM_GLU 4
#endif
#ifndef PROBE_MASK
#define PROBE_MASK 0
#endif
#define REP(bit) for (int rep_ = 0; rep_ < ((PROBE_MASK & (bit)) ? 2 : 1); ++rep_, __syncthreads())
#define GAS __attribute__((address_space(1)))
struct Args { const GAS float* in[28]; GAS float* out; GAS unsigned char* ws; int ph_lo, ph_hi; float rope_inv[64]; };
struct ArgsH { const void* in[28]; void* out; void* ws; int ph_lo, ph_hi; float rope_inv[64]; };
static_assert(sizeof(ArgsH) == 28 * 8 + 8 + 8 + 4 + 4 + 256, "Args layout");
enum { I_X = 0, I_C, I_ADAW, I_ADAB, I_NORMG, I_F1I, I_F1O, I_F2I, I_F2O, I_SWIN, I_SLRE, I_SLIM, I_SLDT, I_SBRE, I_SBIM, I_SCRE, I_SCIM, I_SD, I_SWOUT,
       I_GWIN, I_GWG, I_GBG, I_GNG, I_GWO, I_DWIN, I_DQN, I_DKN, I_DWO };

__device__ __forceinline__ bool relaunder(Frame& F, int wave0) {
    int l_; asm volatile("v_mbcnt_lo_u32_b32 %0, -1, 0\n\tv_mbcnt_hi_u32_b32 %0, -1, %0" : "=v"(l_));
    int w_ = wave0; asm volatile("" : "+s"(w_));
    F.lane = l_; F.wave = w_; F.tid = w_ * 64 + l_;
    int b_ = __builtin_amdgcn_readfirstlane((int)((volatile LAS unsigned*)(F.lds + LDS_MISC))[5]), g_ = gridDim.x; asm volatile("" : "+s"(b_), "+s"(g_)); F.bid = b_; F.G = g_; return true;
}
__device__ __forceinline__ void lds_nan(const Frame& F) {
    const u32x4 nv = {0xffffffffu, 0xffffffffu, 0xffffffffu, 0xffffffffu};
    for (int i = F.tid; i < 131072 / 16; i += NTHREADS) *(LAS u32x4*)(F.lds + 16 * i) = nv;
    __syncthreads();
}
__device__ __forceinline__ const Args* args_ptr() { const Args* p = (const Args*)__builtin_amdgcn_kernarg_segment_ptr(); asm volatile("" : "+s"(p)); return p; }
__global__ void __launch_bounds__(NTHREADS, 2) fwd(Args a) {
    extern __shared__ __attribute__((aligned(16))) unsigned char lds_raw[];
    Frame F;
    F.lds = (LAS unsigned char*)lds_raw; F.tid = threadIdx.x; F.lane = F.tid & 63; F.wave = __builtin_amdgcn_readfirstlane(F.tid >> 6); F.G = gridDim.x; F.bid = blockIdx.x;
#if (PROBE_MASK & 32768)
    for (int i_ = F.tid; i_ < LDS_MISC / 4; i_ += NTHREADS) ((LAS unsigned*)F.lds)[i_] = 0xffffffffu;
#endif
    if (F.tid < 16) ((LAS unsigned*)(F.lds + LDS_MISC))[F.tid] = 0u;
    __syncthreads();
    unsigned char* ws0 = (unsigned char*)a.ws;
    XcdBarrier bar; bar.bar = (unsigned*)(ws0 + WS_CTL); bar.x = 0; bar.st = (volatile LAS unsigned*)(F.lds + LDS_MISC);
    if (!MK_PER_PHASE) bar = xcd_barrier_post((unsigned*)(ws0 + WS_CTL), (volatile LAS unsigned*)(F.lds + LDS_MISC));
    if (F.tid == 0) { volatile LAS unsigned* M_ = (volatile LAS unsigned*)(F.lds + LDS_MISC); const unsigned xcc_ = xb_xcc_id();
        const unsigned rk_ = __hip_atomic_fetch_add((unsigned*)(ws0 + WS_CTL) + 8704 + 64 * xcc_, 1u, __ATOMIC_RELAXED, __HIP_MEMORY_SCOPE_AGENT); M_[4] = rk_ * 8u + xcc_; M_[5] = blockIdx.x; }
    __syncthreads();
    const int lo = a.ph_lo, hi = a.ph_hi, wave0 = F.wave;
    int ph = 0;
#define PH_ON (ph >= lo && ph < hi && relaunder(F, wave0))
#define PH_END do { if (!MK_PER_PHASE && ph >= lo && ph + 1 < hi) { XcdBarrier b2_ = bar; asm volatile("" : "+s"(b2_.bar)); xcd_barrier(b2_); if (PROBE_MASK & 262144) xcd_barrier(b2_); if (ph == 0 && XCC_VB) { if (threadIdx.x == 0) { volatile LAS unsigned* M_ = (volatile LAS unsigned*)(F.lds + LDS_MISC); bool ok_ = gridDim.x == 256; for (int x_ = 0; x_ < 8; ++x_) ok_ = ok_ && __hip_atomic_load(b2_.bar + 8704 + 64 * x_, __ATOMIC_RELAXED, __HIP_MEMORY_SCOPE_AGENT) == 32u; if (ok_) M_[5] = M_[4]; } __syncthreads(); } } if (PROBE_MASK & 65536) { relaunder(F, wave0); lds_nan(F); } ++ph; } while (0)

#define AP (args_ptr())
#define WS(off) ((unsigned char*)(AP->ws + (off)))
#define X ((float*)(AP->out))
#define MOD ((float*)WS(WS_MOD))
#define COS ((float*)WS(WS_COS))
#define SIN ((float*)WS(WS_SIN))
#define W1I ((bf16_t*)WS(WS_W1I))
#define W1O ((bf16_t*)WS(WS_W1O))
#define W2I ((bf16_t*)WS(WS_W2I))
#define W2O ((bf16_t*)WS(WS_W2O))
#define WMI ((bf16_t*)WS(WS_WMI))
#define WMO ((bf16_t*)WS(WS_WMO))
#define H ((bf16_t*)WS(WS_H))
#define B1 ((bf16_t*)WS(WS_B1))
#define IN(i) ((const float*)(AP->in[i]))
    constexpr int NCOL = NMOD * D;

#define CONVERT_LAYER_WEIGHTS() do { convert_matrix<1>(F, IN(I_F1I) + (size_t)layer * D * 2 * DFF, D, 2 * DFF, W1I, DFF); convert_matrix<0>(F, IN(I_F1O) + (size_t)layer * DFF * D, DFF, D, W1O, 0); convert_matrix<1>(F, IN(I_F2I) + (size_t)layer * D * 2 * DFF, D, 2 * DFF, W2I, DFF); convert_matrix<0>(F, IN(I_F2O) + (size_t)layer * DFF * D, DFF, D, W2O, 0); if (kind == 0) { convert_matrix<0>(F, IN(I_SWIN) + (size_t)jm * D * D, D, D, WMI, 0); convert_matrix<1>(F, IN(I_SWOUT) + (size_t)jm * D * 2 * D, D, 2 * D, WMO, D); } else if (kind == 1) { convert_matrix<0>(F, IN(I_GWIN) + (size_t)jm * D * GLA_NPROJ, D, GLA_NPROJ, WMI, 0); zero_bf16(F, WMI + (size_t)GLA_NPROJ * D, (size_t)(GLA_NPAD - GLA_NPROJ) * D / 8); convert_matrix<0>(F, IN(I_GWO) + (size_t)jm * GLA_DV * D, GLA_DV, D, WMO, 0); } else { convert_matrix<0>(F, IN(I_DWIN) + (size_t)jm * D * DSA_QKV, D, DSA_QKV, WMI, 0); convert_matrix<0>(F, IN(I_DWO) + (size_t)jm * DSA_OUT * D, DSA_OUT, D, WMO, 0); } } while (0)
#pragma unroll 1
    for (int layer = 0; layer < DEPTH; ++layer) {
        const int kind = layer % 3, jm = layer / 3;
#define modl (MOD + (size_t)layer * BATCH * NCOL)
        if (layer == 0) {
        if (PH_ON) REP(32) {
            if (layer == 0) { REP(128) mod_phase(F, IN(I_C), IN(I_ADAW), IN(I_ADAB), MOD); REP(4096) rope_phase(F, AP->rope_inv, COS, SIN); }
            if (layer == 0 && (PROBE_MASK & 8192)) { float acc_ = (float)F.tid; const unsigned long long t0_ = __builtin_amdgcn_s_memrealtime(); while (__builtin_amdgcn_s_memrealtime() - t0_ < 30000ull) { _Pragma("unroll") for (int i_ = 0; i_ < 64; ++i_) acc_ = __builtin_fmaf(acc_, 1.0001f, 0.5f); } if (acc_ == 12345.678f) ((float*)WS(WS_B2))[F.tid] = acc_; __syncthreads(); }
            if (layer == 0 && (PROBE_MASK & 16384)) { f32x4 acc_ = {0.f, 0.f, 0.f, 0.f}; const f32x4* src_ = (const f32x4*)IN(I_F2I); for (size_t i_ = (size_t)F.bid * NTHREADS + F.tid; i_ < (size_t)20 * 1024 * 1024; i_ += (size_t)F.G * NTHREADS) acc_ += src_[i_]; if (acc_[0] + acc_[1] + acc_[2] + acc_[3] == 12345.678f) ((float*)WS(WS_B2))[F.tid] = acc_[0]; __syncthreads(); }
            if (layer == 0 && (PROBE_MASK & 1024)) { const unsigned long long t0_ = __builtin_amdgcn_s_memrealtime(); while (__builtin_amdgcn_s_memrealtime() - t0_ < 25000ull) __builtin_amdgcn_s_sleep(8); __syncthreads(); }
            if ((PROBE_MASK >> 20) && layer == (PROBE_MASK >> 20)) { __syncthreads(); mod_phase(F, IN(I_C), IN(I_ADAW), IN(I_ADAB), (float*)WS(WS_B2)); __syncthreads(); }
            if (layer == 0 && (PROBE_MASK & 512)) { __syncthreads(); mod_phase(F, IN(I_C), IN(I_ADAW), IN(I_ADAB), (float*)WS(WS_B2)); rope_phase(F, AP->rope_inv, (float*)WS(WS_B2 + 8 * MiB), (float*)WS(WS_B2 + 16 * MiB)); __syncthreads(); }
            if (layer == 0) CONVERT_LAYER_WEIGHTS();
        }
        PH_END;
        }
#pragma unroll 1
        for (int s = 0; s < 3; ++s) {
#define Xsrc ((layer == 0 && s == 0) ? IN(I_X) : (const float*)X)
#if (PROBE_MASK >> 20) >= 16 && (PROBE_MASK >> 20) < 20
            if (layer == 3 && s == (PROBE_MASK >> 20) - 16 && relaunder(F, wave0)) { mod_phase(F, IN(I_C), IN(I_ADAW), IN(I_ADAB), (float*)WS(WS_END - 2 * MiB)); __syncthreads(); }
#endif
            if (PH_ON) REP(1) { if (layer > 0 && s == 0) CONVERT_LAYER_WEIGHTS();
                norm_phase(F, Xsrc, IN(I_NORMG) + (size_t)(layer * 3 + s) * D, modl + (3 * s) * D, modl + (3 * s + 1) * D, NCOL, H, (layer == 0 && s == 0) ? (float*)X : (float*)nullptr); }
            PH_END;
            const int nin = (s != 1) ? 2 * DFF : (kind == 0 ? D : kind == 1 ? GLA_NPAD : DSA_QKV);
            if (PH_ON) {
                if (s != 1) for (int rep_ = 0; rep_ < ((PROBE_MASK & (16 | 2048)) ? 2 : 1); ++rep_, __syncthreads()) { relaunder(F, wave0); pg8::Gemm g{H, (s == 0) ? W1I : W2I, MTOK, 2 * DFF, D}; pg8::StaticOrder S; S.init(MTOK, 2 * DFF, F.G, F.bid, WGM_SWIGLU);
                    pg8::EpiSwiGLU E{((PROBE_MASK & 2048) && rep_) ? (bf16_t*)WS(WS_B2) : B1, DFF}; pg8::gemm_phase<pg8::EpiSwiGLU, pg8::StaticOrder, true, true>(F.lds, g, S, E, F.tid); }
                else { pg8::Gemm g{H, WMI, MTOK, nin, D}; pg8::StaticOrder S; S.init(MTOK, nin, F.G, F.bid, WGM_BF16);
                    pg8::EpiBf16P E{B1, nin}; pg8::gemm_phase<pg8::EpiBf16P, pg8::StaticOrder, true, true>(F.lds, g, S, E, F.tid); }
            }
            PH_END;
#if (PROBE_MASK & 2048)
                if (s != 1 && relaunder(F, wave0)) {
                    pg8::StaticOrder S; S.init(MTOK, 2 * DFF, F.G, F.bid, WGM_SWIGLU); pg8::Unit u_; unsigned bad_ = 0;
                    for (int i_ = 0; S.next(i_, u_); ++i_) for (int q_ = F.tid; q_ < 256 * 16; q_ += NTHREADS) { const int r_ = u_.pm * 256 + (q_ >> 4), c_ = u_.pn * 128 + (q_ & 15) * 8;
                        const u32x4 a_ = *(const u32x4*)(B1 + (size_t)r_ * DFF + c_), b_ = *(const u32x4*)((bf16_t*)WS(WS_B2) + (size_t)r_ * DFF + c_);
                        bad_ += (a_.x != b_.x) | (a_.y != b_.y) | (a_.z != b_.z) | (a_.w != b_.w); }
                    if (bad_) atomicAdd((unsigned*)WS(WS_CTL) + 8192, bad_); }
#endif
            if (s == 1) {
                if (kind == 0) {

                    if (PH_ON) REP(2) s5_pass1(F, jm, B1, IN(I_SLRE), IN(I_SLIM), IN(I_SLDT), IN(I_SBRE), IN(I_SBIM), (float*)WS(WS_S5E));
                    PH_END;
                    if (PH_ON) REP(2) s5_scan<2>(F, jm, B1, IN(I_SLRE), IN(I_SLIM), IN(I_SLDT), IN(I_SBRE), IN(I_SBIM), IN(I_SCRE), IN(I_SCIM), (float*)WS(WS_S5E), (bf16_t*)WS(S5_YF), (bf16_t*)WS(S5_YB));
                    PH_END;
                    if (PH_ON) REP(64) s5_post(F, (bf16_t*)WS(S5_YF), (bf16_t*)WS(S5_YB), B1, IN(I_SD) + (size_t)jm * D, H);
                    PH_END;
                } else if (kind == 1) {

                    if (PH_ON) REP(4) gla_a(F, jm, B1, IN(I_GWG), IN(I_GBG), (bf16_t*)WS(GLA_QD), (bf16_t*)WS(GLA_KL), (bf16_t*)WS(GLA_ATT), (float*)WS(GLA_DEC));
                    PH_END;
                    if (PH_ON) REP(4) { gla_b<1>(F, B1, (bf16_t*)WS(GLA_QD), (bf16_t*)WS(GLA_KL), (bf16_t*)WS(GLA_ATT), (float*)WS(GLA_DEC), (bf16_t*)WS(GLA_OD), (float*)WS(WS_H));
                        { asm volatile("s_waitcnt vmcnt(0)" ::: "memory"); __syncthreads(); XcdBarrier b4_ = bar; asm volatile("" : "+s"(b4_.bar)); xcd_barrier(b4_); relaunder(F, wave0); }
                        gla_b<2>(F, B1, (bf16_t*)WS(GLA_QD), (bf16_t*)WS(GLA_KL), (bf16_t*)WS(GLA_ATT), (float*)WS(GLA_DEC), (bf16_t*)WS(GLA_OD), (float*)WS(WS_H)); }
                    PH_END;
                    if (PH_ON) REP(64) gla_c(F, B1, (bf16_t*)WS(GLA_OD), IN(I_GNG) + (size_t)jm * GLA_DV, H);
                    PH_END;
                } else {

                    if (PH_ON) dsa_norm(F, B1, IN(I_DQN) + (size_t)jm * DSA_G * DSA_HD, IN(I_DKN) + (size_t)jm * DSA_G * DSA_HD, COS, SIN);
                    PH_END;
                    if (PH_ON) REP(8) dsa_attn(F, B1, (float*)WS(DSA_PO), (float*)WS(DSA_LSE));
                    PH_END;
                    if (PH_ON) REP(64) dsa_merge(F, (float*)WS(DSA_PO), (float*)WS(DSA_LSE), H);
                    PH_END;
                }
            }
#if (PROBE_MASK >> 20) == 20
            if (layer == 3 && s == 2 && relaunder(F, wave0)) { mod_phase(F, IN(I_C), IN(I_ADAW), IN(I_ADAB), (float*)WS(WS_END - 2 * MiB)); __syncthreads(); }
#endif
            if (PH_ON) {
                if (s == 1 && kind == 0) { pg8::Gemm g{H, WMO, MTOK, 2 * D, D}; pg8::StaticOrder S; S.init(MTOK, 2 * D, F.G, F.bid, WGM_GLU);
                    pg8::EpiGLURes E{X, D, modl + 5 * D, NCOL, SEQ}; pg8::gemm_phase<pg8::EpiGLURes, pg8::StaticOrder, true, true>(F.lds, g, S, E, F.tid); }
                else { const int kout = (s != 1) ? DFF : (kind == 1 ? GLA_DV : DSA_OUT);
#if (PROBE_MASK & 131072)
                    const int nrep_ = (layer == 3 && s == 2) ? 3 : 1;
                    for (int rep_ = 0; rep_ < nrep_; ++rep_) { relaunder(F, wave0);
                    float* outp_ = (nrep_ == 3 && rep_ < 2) ? (float*)WS(WS_B2 + (size_t)rep_ * 256 * MiB) : X;
                    if (nrep_ == 3 && rep_ < 2) { pg8::StaticOrder S; S.init(MTOK, D, F.G, F.bid, WGM_RES); pg8::Unit u_;
                        for (int i_ = 0; S.next(i_, u_); ++i_) for (int q_ = F.tid; q_ < 256 * 64; q_ += NTHREADS) { const size_t o_ = (size_t)(u_.pm * 256 + (q_ >> 6)) * D + u_.pn * 256 + (q_ & 63) * 4;
                            *(u32x4*)(outp_ + o_) = *(const u32x4*)(X + o_); }
                        asm volatile("s_waitcnt vmcnt(0)" ::: "memory"); __syncthreads(); relaunder(F, wave0); }
                    if (nrep_ == 3 && rep_ == 1) { mod_phase(F, IN(I_C), IN(I_ADAW), IN(I_ADAB), (float*)WS(WS_END - 2 * MiB)); __syncthreads(); relaunder(F, wave0); }
                    { pg8::Gemm g{(s != 1) ? (const bf16_t*)B1 : (const bf16_t*)H, (s == 0) ? W1O : (s == 2) ? W2O : WMO, MTOK, D, kout}; pg8::StaticOrder S; S.init(MTOK, D, F.G, F.bid, WGM_RES);
                    pg8::EpiRes E{outp_, D, modl + (3 * s + 2) * D, NCOL, (s != 1) ? 0.5f : 1.0f, SEQ}; pg8::gemm_phase<pg8::EpiRes, pg8::StaticOrder, true, true>(F.lds, g, S, E, F.tid); }
                    asm volatile("s_waitcnt vmcnt(0)" ::: "memory"); __syncthreads();
                    if (nrep_ == 3 && rep_ == 1) { relaunder(F, wave0); pg8::StaticOrder S; S.init(MTOK, D, F.G, F.bid, WGM_RES); pg8::Unit u_; unsigned bad_ = 0;
                        const float* y1_ = (const float*)WS(WS_B2); const float* y2_ = (const float*)WS(WS_B2 + (size_t)256 * MiB);
                        for (int i_ = 0; S.next(i_, u_); ++i_) for (int q_ = F.tid; q_ < 256 * 64; q_ += NTHREADS) { const size_t o_ = (size_t)(u_.pm * 256 + (q_ >> 6)) * D + u_.pn * 256 + (q_ & 63) * 4;
                            const u32x4 a_ = *(const u32x4*)(y1_ + o_), b_ = *(const u32x4*)(y2_ + o_); bad_ += (a_.x != b_.x) + (a_.y != b_.y) + (a_.z != b_.z) + (a_.w != b_.w); }
                        if (bad_) atomicAdd((unsigned*)WS(WS_CTL) + 8192, bad_); __syncthreads(); }
                    } }
#else
                    for (int rep_ = ((PROBE_MASK & 524288) ? 0 : 1); rep_ < 2; ++rep_) { relaunder(F, wave0);
                    pg8::Gemm g{(s != 1) ? (const bf16_t*)B1 : (const bf16_t*)H, (s == 0) ? W1O : (s == 2) ? W2O : WMO, MTOK, D, kout}; pg8::StaticOrder S; S.init(MTOK, D, F.G, F.bid, WGM_RES);
                    pg8::EpiRes E{X, D, modl + (3 * s + 2) * D, NCOL, rep_ ? ((s != 1) ? 0.5f : 1.0f) : 0.0f, SEQ}; pg8::gemm_phase<pg8::EpiRes, pg8::StaticOrder, true, true>(F.lds, g, S, E, F.tid); __syncthreads(); } }
#endif
            }
            PH_END;
        }
    }
#if (PROBE_MASK & (2048 | 131072))
    { asm volatile("s_waitcnt vmcnt(0)" ::: "memory"); __syncthreads(); XcdBarrier b2_ = bar; xcd_barrier(b2_);
      const unsigned nb_ = __hip_atomic_load((unsigned*)WS(WS_CTL) + 8192, __ATOMIC_RELAXED, __HIP_MEMORY_SCOPE_AGENT);
      relaunder(F, wave0); if (nb_ && F.bid == 0 && F.tid < 64) X[F.tid] = __builtin_nanf(""); }
#endif
#undef PH_ON
#undef PH_END
#undef CONVERT_LAYER_WEIGHTS
#undef AP
#undef WS
#undef X
#undef MOD
#undef COS
#undef SIN
#undef W1I
#undef W1O
#undef W2I
#undef W2O
#undef WMI
#undef WMO
#undef H
#undef B1
#undef IN
#undef modl
#undef Xsrc
}

extern "C" void kernel_launch(void* const* d_in, const int* in_sizes, int n_in, void* d_out, int out_size, void* d_ws, size_t ws_size, hipStream_t stream) {
    static int grid = 0;
    if (grid == 0) {
        if (n_in != 28 || in_sizes[0] != MTOK * D || out_size != MTOK * D || ws_size < WS_END) {
            fprintf(stderr, "kernel_launch: unexpected problem (n_in %d, in0 %d, out %d, ws %zu < %zu?); nothing launched\n", n_in, n_in > 0 ? in_sizes[0] : -1, out_size, ws_size, (size_t)WS_END); grid = -1; return; }
        int dev = 0, cus = 0, per_cu = 0;
        if (hipGetDevice(&dev) != hipSuccess || hipDeviceGetAttribute(&cus, hipDeviceAttributeMultiprocessorCount, dev) != hipSuccess) { grid = -1; return; }
        if (hipFuncSetAttribute((const void*)fwd, hipFuncAttributeMaxDynamicSharedMemorySize, LDS_BYTES) != hipSuccess) { fprintf(stderr, "kernel_launch: hipFuncSetAttribute failed\n"); grid = -1; return; }
        if (hipOccupancyMaxActiveBlocksPerMultiprocessor(&per_cu, (const void*)fwd, NTHREADS, LDS_BYTES) != hipSuccess || per_cu < 1) { fprintf(stderr, "kernel_launch: occupancy query says %d blocks per CU\n", per_cu); }
        (void)hipGetLastError();
        if (cus < 256) { fprintf(stderr, "kernel_launch: built for a 256-CU device (MI355X), found %d CUs; nothing launched\n", cus); grid = -1; return; }
        grid = 256;
    }
    if (grid < 0) return;
    if (hipMemsetAsync((char*)d_ws + WS_CTL, 0, CTL_ZERO_BYTES, stream) != hipSuccess) return;
#if (PROBE_MASK & 32768)
    (void)hipMemsetAsync((char*)d_ws + WS_MOD, 0xFF, WS_END - WS_MOD, stream); (void)hipMemsetAsync(d_out, 0xFF, (size_t)MTOK * D * 4, stream);
#endif
    ArgsH a{};
    for (int i = 0; i < 28; ++i) a.in[i] = d_in[i];
    a.out = d_out; a.ws = d_ws;
    for (int j = 0; j < 64; ++j) a.rope_inv[j] = (float)pow(10000.0, -(double)j / 64.0);
#if MK_PER_PHASE
    for (int p = 0; p < N_PHASES; ++p) { a.ph_lo = p; a.ph_hi = p + 1; void* kargs[] = {&a}; (void)hipLaunchKernel((const void*)fwd, dim3(grid), dim3(NTHREADS), kargs, LDS_BYTES, stream); }
#else
    a.ph_lo = 0; a.ph_hi = N_PHASES;
    void* kargs[] = {&a};
    if (hipLaunchKernel((const void*)fwd, dim3(grid), dim3(NTHREADS), kargs, LDS_BYTES, stream) != hipSuccess) fprintf(stderr, "kernel_launch: launch failed\n");
#endif
}
```

```cpp
#define WGM_RES 2
#include <hip/hip_runtime.h>
#include <cstdio>
#include <cstdint>
#include <cmath>
#define XB_TMO      128
#define XB_XCNT(j)  (256  + 64 * (j))
#define XB_XSUB(j)  (1280 + 64 * (j))
#define XB_XGEN(j)  (2304 + 64 * (j))
#define XB_TOP      3328
#define XB_TOPGEN   3392
#define XCD_BAR_WORDS 3456
#define XB_SPIN_CAP (1u << 21)
#define LAS __attribute__((address_space(3)))

__device__ __forceinline__ unsigned xb_ld(unsigned* p)              { return __hip_atomic_load(p, __ATOMIC_RELAXED, __HIP_MEMORY_SCOPE_AGENT); }
__device__ __forceinline__ unsigned xb_add(unsigned* p, unsigned v) { return __hip_atomic_fetch_add(p, v, __ATOMIC_RELAXED, __HIP_MEMORY_SCOPE_AGENT); }
__device__ __forceinline__ unsigned xb_xcc_id() { return (unsigned)__builtin_amdgcn_s_getreg((3 << 11) | 20) & 0xFu; }
#define XB_SPIN(cond, bar) do { unsigned _sp = 0; while (cond) { __builtin_amdgcn_s_sleep(1); \
    if ((++_sp & 255u) == 0u) { if (xb_ld(&(bar)[XB_TMO])) break; if (_sp > XB_SPIN_CAP) { atomicAdd(&(bar)[XB_TMO], 1u); break; } } } } while (0)

struct XcdBarrier {
    unsigned* bar; unsigned x;
    volatile LAS unsigned* st;
};

__device__ __forceinline__ XcdBarrier xcd_barrier_post(unsigned* bar, volatile LAS unsigned* st) {
    XcdBarrier b; b.bar = bar; b.x = xb_xcc_id(); b.st = st;
    if (threadIdx.x == 0) (void)xb_add(&bar[XB_XCNT(b.x)], 1u);
    return b;
}
__device__ __forceinline__ void xcd_barrier_complete(unsigned* bar, unsigned x, unsigned& nloc, unsigned& nx) {
    const unsigned G = gridDim.x * gridDim.y * gridDim.z;
    unsigned sum, cnt, mine, sp = 0u;
    for (;;) {
        sum = 0u; cnt = 0u; mine = 0u;
#pragma unroll
        for (unsigned j = 0; j < 16; ++j) { const unsigned c = xb_ld(&bar[XB_XCNT(j)]); sum += c; cnt += (c > 0u) ? 1u : 0u; mine = (j == x) ? c : mine; }
        if (sum == G) break;
        __builtin_amdgcn_s_sleep(1);
        if ((++sp & 255u) == 0u) { if (xb_ld(&bar[XB_TMO])) break; if (sp > XB_SPIN_CAP) { atomicAdd(&bar[XB_TMO], 1u); break; } }
    }
    nloc = mine > 0u ? mine : 1u; nx = cnt > 0u ? cnt : 1u;
}

__device__ __forceinline__ void xcd_barrier(const XcdBarrier& b) {
    asm volatile("s_waitcnt vmcnt(0)" ::: "memory");
    __syncthreads();
    if (threadIdx.x == 0) {
        unsigned* bar = b.bar;
        __builtin_amdgcn_s_waitcnt(0);
        unsigned nloc = b.st[0], nx = b.st[1];
        if (nloc == 0u) { xcd_barrier_complete(bar, b.x, nloc, nx); b.st[0] = nloc; b.st[1] = nx; }
        const unsigned old = xb_add(&bar[XB_XSUB(b.x)], 1u);
        const unsigned gen = old / nloc;
        if (old + 1u == (gen + 1u) * nloc) {
            __builtin_amdgcn_fence(__ATOMIC_RELEASE, "agent");
            asm volatile("s_waitcnt vmcnt(0)" ::: "memory");
            const unsigned og = xb_add(&bar[XB_TOP], 1u);
            const unsigned tg = og / nx;
            if (og + 1u == (tg + 1u) * nx) xb_add(&bar[XB_TOPGEN], 1u);
            else XB_SPIN(xb_ld(&bar[XB_TOPGEN]) == tg, bar);
            __builtin_amdgcn_fence(__ATOMIC_ACQUIRE, "agent");
            xb_add(&bar[XB_XGEN(b.x)], 1u);
            asm volatile("s_waitcnt vmcnt(0)" ::: "memory");
        } else {
            XB_SPIN(xb_ld(&bar[XB_XGEN(b.x)]) == gen, bar);
            __builtin_amdgcn_fence(__ATOMIC_ACQUIRE, "agent");
            asm volatile("s_waitcnt vmcnt(0)" ::: "memory");
        }
    }
    __syncthreads();
}
namespace pg8 {
#define PG8_LAS __attribute__((address_space(3)))
typedef unsigned short bf16_t;
typedef short bf16x8 __attribute__((ext_vector_type(8)));
typedef float f32x4 __attribute__((ext_vector_type(4)));
typedef unsigned u32x4 __attribute__((ext_vector_type(4)));
typedef unsigned u32x2 __attribute__((ext_vector_type(2)));
constexpr int BM = 256, BK = 64, HALF = 128, HTB = HALF * BK * 2  , STAGE_BYTES = 8 * HTB, NXCD = 8, WGM = 8;

__host__ __device__ __forceinline__ int lds_byte(int r, int c) { const int st = (r >> 4) * 2 + (c >> 5), rr = r & 15, cc = c & 31, ob = rr * 64 + cc * 2; return st * 1024 + (ob ^ (((ob >> 9) & 1) << 5)); }
__host__ __device__ __forceinline__ void stage_rc(int b, int& R, int& C) { const int st = b / 1024, sb = b % 1024, swz = sb ^ (((sb >> 9) & 1) << 5); R = (st >> 1) * 16 + swz / 64; C = (st & 1) * 32 + (swz % 64) / 2; }
__host__ __device__ __forceinline__ int perm32(int rho) { const int n = rho >> 4, i = rho & 15; return 8 * (i >> 2) + 4 * n + (i & 3); }

struct Unit { int pm, pn; };
struct Gemm { const bf16_t* A; const bf16_t* Bt; int M, N, K; };

struct StaticOrder {
    int nM, nN, nwg, G, c, wgm;
    __host__ __device__ void init(int M, int N, int G_, int c_, int wgm_ = WGM) { nM = M / BM; nN = N / BM; nwg = nM * nN; G = G_; c = c_; wgm = wgm_; }
    __host__ __device__ bool next(int i, Unit& u) const {
        const long L = (long)i * G + c; if (L >= nwg) return false;
        int wgid = (int)L; { const int q = nwg / NXCD, r = nwg % NXCD, xcd = wgid % NXCD, off = wgid / NXCD; wgid = (xcd < r ? xcd * (q + 1) : r * (q + 1) + (xcd - r) * q) + off; }
        const int nig = wgm * nN, gid = wgid / nig, fm = gid * wgm, gsz = (nM - fm) < wgm ? (nM - fm) : wgm;
        u.pm = fm + ((wgid % nig) % gsz); u.pn = (wgid % nig) / gsz; return true;
    }
    __device__ __forceinline__ void a_ready(const Unit&) const {}
    __device__ __forceinline__ void done(const Unit&) const {}
};
typedef __bf16 bf16v2 __attribute__((ext_vector_type(2)));
__device__ __forceinline__ unsigned cvt_pk_bf16(float lo, float hi) { bf16v2 v; v[0] = (__bf16)lo; v[1] = (__bf16)hi; return __builtin_bit_cast(unsigned, v); }
typedef float f32x2 __attribute__((ext_vector_type(2)));
__device__ __forceinline__ float sigmoid_fast(float x) { return __builtin_amdgcn_rcpf(1.0f + __expf(-x)); }
struct EpiSwiGLU {
    static constexpr bool PERM = true, AFTER_DRAIN = false;
    bf16_t* O; int ldc;
    __device__ __forceinline__ void operator()(const f32x4 (&acc)[2][2][4][2], const Unit& u, int wr, int wc, int fr, int fq) const {
        const int row0 = u.pm * BM + wr * 64 + fr, col0 = u.pn * HALF + wc * 32 + 8 * fq;
#pragma unroll
        for (int ai = 0; ai < 2; ++ai)
#pragma unroll
            for (int m = 0; m < 4; ++m) { bf16_t* rowp = O + (size_t)(row0 + ai * HALF + m * 16) * ldc + col0;
                float v[8];
#pragma unroll
                for (int n = 0; n < 2; ++n)
#pragma unroll
                    for (int i = 0; i < 4; ++i) { const float g = acc[ai][0][m][n][i], uu = acc[ai][1][m][n][i]; v[4 * n + i] = g * sigmoid_fast(g) * uu; }
                u32x4 w; w.x = cvt_pk_bf16(v[0], v[1]); w.y = cvt_pk_bf16(v[2], v[3]); w.z = cvt_pk_bf16(v[4], v[5]); w.w = cvt_pk_bf16(v[6], v[7]);
                *(u32x4*)rowp = w; }
    }
};
struct EpiBf16P {
    static constexpr bool PERM = true, AFTER_DRAIN = false;
    bf16_t* O; int ldc;
    __device__ __forceinline__ void operator()(const f32x4 (&acc)[2][2][4][2], const Unit& u, int wr, int wc, int fr, int fq) const {
        const int row0 = u.pm * BM + wr * 64 + fr, col0 = u.pn * BM + wc * 32 + 8 * fq;
#pragma unroll
        for (int ai = 0; ai < 2; ++ai)
#pragma unroll
            for (int m = 0; m < 4; ++m) { bf16_t* rowp = O + (size_t)(row0 + ai * HALF + m * 16) * ldc + col0;
#pragma unroll
                for (int bj = 0; bj < 2; ++bj) { const f32x4 v0 = acc[ai][bj][m][0], v1 = acc[ai][bj][m][1];
                    u32x4 w; w.x = cvt_pk_bf16(v0[0], v0[1]); w.y = cvt_pk_bf16(v0[2], v0[3]); w.z = cvt_pk_bf16(v1[0], v1[1]); w.w = cvt_pk_bf16(v1[2], v1[3]);
                    *(u32x4*)(rowp + bj * HALF) = w; } }
    }
};
struct EpiRes {
    static constexpr bool PERM = false, AFTER_DRAIN = false;
    float* x; int ldc; const float* gate; int gate_bstride; float gscale; int rows_per_batch;
    __device__ __forceinline__ void operator()(const f32x4 (&acc)[2][2][4][2], const Unit& u, int wr, int wc, int fr, int fq) const {
        const int row0 = u.pm * BM + wr * 64 + fr, col0 = u.pn * BM + wc * 32 + 4 * fq;
        const float* gp = gate + (size_t)((u.pm * BM) / rows_per_batch) * gate_bstride + col0;
        f32x4 gv[2][2];
#pragma unroll
        for (int bj = 0; bj < 2; ++bj)
#pragma unroll
            for (int n = 0; n < 2; ++n) gv[bj][n] = *(const f32x4*)(gp + bj * HALF + n * 16) * gscale;
#pragma unroll
        for (int ai = 0; ai < 2; ++ai)
#pragma unroll
        for (int mh = 0; mh < 2; ++mh) {
            f32x4 bs[2][2][2];
#pragma unroll
            for (int mm = 0; mm < 2; ++mm) { const size_t off = (size_t)(row0 + ai * HALF + (2 * mh + mm) * 16) * ldc + col0;
#pragma unroll
                for (int bj = 0; bj < 2; ++bj)
#pragma unroll
                    for (int n = 0; n < 2; ++n) bs[mm][bj][n] = *(const f32x4*)(x + off + bj * HALF + n * 16); }
#pragma unroll
            for (int mm = 0; mm < 2; ++mm) { const size_t off = (size_t)(row0 + ai * HALF + (2 * mh + mm) * 16) * ldc + col0;
#pragma unroll
                for (int bj = 0; bj < 2; ++bj)
#pragma unroll
                    for (int n = 0; n < 2; ++n) *(f32x4*)(x + off + bj * HALF + n * 16) = bs[mm][bj][n] + gv[bj][n] * acc[ai][bj][2 * mh + mm][n]; }
            asm volatile("" ::: "memory"); }
    }
};
struct EpiGLURes {
    static constexpr bool PERM = true, AFTER_DRAIN = false;
    float* x; int ldc; const float* gate; int gate_bstride; int rows_per_batch;
    __device__ __forceinline__ void operator()(const f32x4 (&acc)[2][2][4][2], const Unit& u, int wr, int wc, int fr, int fq) const {
        const int row0 = u.pm * BM + wr * 64 + fr, col0 = u.pn * HALF + wc * 32 + 8 * fq;
        const float* gp = gate + (size_t)((u.pm * BM) / rows_per_batch) * gate_bstride + col0;
        const f32x4 gv0 = *(const f32x4*)gp, gv1 = *(const f32x4*)(gp + 4);
#pragma unroll
        for (int ai = 0; ai < 2; ++ai) {
            f32x4 b0[4], b1[4];
#pragma unroll
            for (int m = 0; m < 4; ++m) { const size_t off = (size_t)(row0 + ai * HALF + m * 16) * ldc + col0; b0[m] = *(const f32x4*)(x + off); b1[m] = *(const f32x4*)(x + off + 4); }
#pragma unroll
            for (int m = 0; m < 4; ++m) { const size_t off = (size_t)(row0 + ai * HALF + m * 16) * ldc + col0;
                f32x4 y0, y1;
#pragma unroll
                for (int i = 0; i < 4; ++i) { y0[i] = acc[ai][0][m][0][i] * sigmoid_fast(acc[ai][1][m][0][i]); y1[i] = acc[ai][0][m][1][i] * sigmoid_fast(acc[ai][1][m][1][i]); }
                *(f32x4*)(x + off) = b0[m] + gv0 * y0; *(f32x4*)(x + off + 4) = b1[m] + gv1 * y1; }
            asm volatile("" ::: "memory"); }
    }
};
template <class Epi, class Sched, bool ALIGN_EPI = false, bool SP2 = false>
__device__ __forceinline__ void gemm_phase(PG8_LAS unsigned char* lds, const Gemm g, const Sched& S, const Epi& E, const int tid) {
    const int wid = __builtin_amdgcn_readfirstlane(tid >> 6), lane = tid & 63, wr = wid >> 2, wc = wid & 3, fr = lane & 15, fq = lane >> 4;
    const int K = g.K, nt = K / BK;
    unsigned voffA[2], voffB[2];
#pragma unroll
    for (int i = 0; i < 2; ++i) { int R, C; stage_rc(tid * 16 + i * 8192, R, C); const int Rb = Epi::PERM ? ((R & ~31) + perm32(R & 31)) : R;
        voffA[i] = (unsigned)(R * K + C) * 2u; voffB[i] = (unsigned)(Rb * K + C) * 2u; }
    const size_t kstep = (size_t)(BK * 2);
    const size_t hstep = (size_t)HALF * K * 2;
    const size_t tstep = 2 * hstep;
    const unsigned ldsw = (unsigned)wid * 1024u;
    const int aoff = lds_byte(wr * 64 + fr, fq * 8), boff = lds_byte(wc * 32 + fr, fq * 8);
#define PG8_SA(b, h) (((b) * 2 + (h)) * HTB)
#define PG8_SB(b, h) ((4 + (b) * 2 + (h)) * HTB)
#define PG8_STAGE(bufoff, gbase, voff) do { _Pragma("unroll") for (int _i = 0; _i < 2; ++_i) \
        __builtin_amdgcn_global_load_lds((const unsigned*)((const char*)(gbase) + (voff)[_i]), (PG8_LAS unsigned*)(lds + (bufoff) + ldsw + _i * 8192), 16, 0, 0); } while (0)
#define PG8_LDA(dst, b, h) do { _Pragma("unroll") for (int m = 0; m < 4; ++m) _Pragma("unroll") for (int k = 0; k < 2; ++k) dst[m][k] = *(const PG8_LAS bf16x8*)(lds + PG8_SA(b, h) + aoff + m * 2048 + k * 1024); } while (0)
#define PG8_LDB(dst, b, h) do { _Pragma("unroll") for (int n = 0; n < 2; ++n) _Pragma("unroll") for (int k = 0; k < 2; ++k) dst[n][k] = *(const PG8_LAS bf16x8*)(lds + PG8_SB(b, h) + boff + n * 2048 + k * 1024); } while (0)
#define PG8_MMA(ai, bj, At, Bt) do { __builtin_amdgcn_s_setprio(1); _Pragma("unroll") for (int m = 0; m < 4; ++m) _Pragma("unroll") for (int n = 0; n < 2; ++n) _Pragma("unroll") for (int k = 0; k < 2; ++k) \
        acc[ai][bj][m][n] = __builtin_amdgcn_mfma_f32_16x16x32_bf16(Bt[n][k], At[m][k], acc[ai][bj][m][n], 0, 0, 0); __builtin_amdgcn_s_setprio(0); } while (0)
#define PG8_WAIT_V(n) asm volatile("s_waitcnt vmcnt(" #n ")" ::: "memory")
#define PG8_WAIT_L(n) asm volatile("s_waitcnt lgkmcnt(" #n ")" ::: "memory")
#define PG8_BAR __builtin_amdgcn_s_barrier()
#define PG8_SCHED __builtin_amdgcn_sched_barrier(0)
    Unit cur, nxt; int ui = 0;
    if (!S.next(0, cur)) return;
    f32x4 acc[2][2][4][2];
#pragma unroll
    for (int a = 0; a < 2; ++a)
#pragma unroll
        for (int b = 0; b < 2; ++b)
#pragma unroll
            for (int m = 0; m < 4; ++m)
#pragma unroll
                for (int n = 0; n < 2; ++n) acc[a][b][m][n] = (f32x4){0.f, 0.f, 0.f, 0.f};
    bf16x8 At[4][2], B0[2][2], B1[2][2];
    const char* cA = (const char*)g.A + (size_t)cur.pm * tstep; const char* cB = (const char*)g.Bt + (size_t)cur.pn * tstep;
    S.a_ready(cur);
    if constexpr (SP2) {
        PG8_STAGE(PG8_SB(0, 0), cB, voffB); PG8_STAGE(PG8_SB(0, 1), cB + hstep, voffB); PG8_STAGE(PG8_SA(0, 0), cA, voffA); PG8_STAGE(PG8_SA(0, 1), cA + hstep, voffA);
        if (wr == 1) PG8_BAR;
        PG8_WAIT_V(2); PG8_BAR;
        PG8_STAGE(PG8_SB(1, 0), cB + kstep, voffB); PG8_STAGE(PG8_SA(1, 0), cA + kstep, voffA); PG8_STAGE(PG8_SB(1, 1), cB + hstep + kstep, voffB);
        PG8_WAIT_V(6); PG8_BAR;
    } else {
        PG8_STAGE(PG8_SB(0, 0), cB, voffB); PG8_STAGE(PG8_SA(0, 0), cA, voffA); PG8_STAGE(PG8_SB(0, 1), cB + hstep, voffB); PG8_STAGE(PG8_SA(0, 1), cA + hstep, voffA);
        if (wr == 1) PG8_BAR;
        PG8_WAIT_V(4); PG8_BAR;
        PG8_STAGE(PG8_SB(1, 0), cB + kstep, voffB); PG8_STAGE(PG8_SA(1, 0), cA + kstep, voffA); PG8_STAGE(PG8_SB(1, 1), cB + hstep + kstep, voffB);
        PG8_WAIT_V(6); PG8_BAR;
    }
    for (;;) {
        const bool has_next = S.next(ui + 1, nxt);
        const char* nA = has_next ? (const char*)g.A + (size_t)nxt.pm * tstep : cA; const char* nB = has_next ? (const char*)g.Bt + (size_t)nxt.pn * tstep : cB;
        for (int t = 0; t < nt; t += 2) {
            const bool last = (t == nt - 2);
            const char* a1 = cA + (size_t)(t + 1) * kstep;
            const char* a2 = last ? nA : cA + (size_t)(t + 2) * kstep; const char* b2 = last ? nB : cB + (size_t)(t + 2) * kstep;
            const char* a3 = a2 + kstep; const char* b3 = b2 + kstep;
            if (last && has_next) S.a_ready(nxt);
            if constexpr (SP2) {
            PG8_LDB(B0, 0, 0); PG8_LDB(B1, 0, 1); PG8_SCHED; PG8_LDA(At, 0, 0); PG8_STAGE(PG8_SA(1, 1), a1 + hstep, voffA);
            PG8_WAIT_V(8); PG8_WAIT_L(0); PG8_BAR; PG8_MMA(0, 0, At, B0); PG8_MMA(0, 1, At, B1); PG8_BAR; PG8_SCHED;
            PG8_LDA(At, 0, 1); PG8_STAGE(PG8_SB(0, 0), b2, voffB); PG8_STAGE(PG8_SB(0, 1), b2 + hstep, voffB); PG8_STAGE(PG8_SA(0, 0), a2, voffA);
            PG8_WAIT_V(8); PG8_WAIT_L(0); PG8_BAR; PG8_MMA(1, 0, At, B0); PG8_MMA(1, 1, At, B1); PG8_BAR; PG8_SCHED;
            PG8_LDB(B0, 1, 0); PG8_LDB(B1, 1, 1); PG8_SCHED; PG8_LDA(At, 1, 0); PG8_STAGE(PG8_SA(0, 1), a2 + hstep, voffA);
            PG8_WAIT_V(8); PG8_WAIT_L(0); PG8_BAR; PG8_MMA(0, 0, At, B0); PG8_MMA(0, 1, At, B1); PG8_BAR; PG8_SCHED;
            PG8_LDA(At, 1, 1); PG8_STAGE(PG8_SB(1, 0), b3, voffB); PG8_STAGE(PG8_SB(1, 1), b3 + hstep, voffB); PG8_STAGE(PG8_SA(1, 0), a3, voffA);
            PG8_WAIT_V(8); PG8_WAIT_L(0); PG8_BAR; PG8_MMA(1, 0, At, B0); PG8_MMA(1, 1, At, B1); PG8_BAR; PG8_SCHED;
            } else {
            PG8_LDB(B0, 0, 0); PG8_SCHED; PG8_LDA(At, 0, 0); PG8_STAGE(PG8_SA(1, 1), a1 + hstep, voffA);
            PG8_WAIT_L(8); PG8_BAR; PG8_WAIT_L(0); PG8_MMA(0, 0, At, B0); PG8_BAR; PG8_SCHED;
            PG8_LDB(B1, 0, 1); PG8_STAGE(PG8_SB(0, 0), b2, voffB);
            PG8_BAR; PG8_WAIT_L(0); PG8_MMA(0, 1, At, B1); PG8_BAR;
            PG8_LDA(At, 0, 1); PG8_STAGE(PG8_SA(0, 0), a2, voffA);
            PG8_BAR; PG8_WAIT_L(0); PG8_MMA(1, 0, At, B0); PG8_BAR; PG8_SCHED;
            PG8_STAGE(PG8_SB(0, 1), b2 + hstep, voffB);
            PG8_WAIT_V(6); PG8_BAR; PG8_MMA(1, 1, At, B1); PG8_BAR;
            PG8_LDB(B0, 1, 0); PG8_SCHED; PG8_LDA(At, 1, 0); PG8_STAGE(PG8_SA(0, 1), a2 + hstep, voffA);
            PG8_WAIT_L(8); PG8_BAR; PG8_WAIT_L(0); PG8_MMA(0, 0, At, B0); PG8_BAR; PG8_SCHED;
            PG8_LDB(B1, 1, 1); PG8_STAGE(PG8_SB(1, 0), b3, voffB);
            PG8_BAR; PG8_WAIT_L(0); PG8_MMA(0, 1, At, B1); PG8_BAR;
            PG8_LDA(At, 1, 1); PG8_STAGE(PG8_SA(1, 0), a3, voffA);
            PG8_BAR; PG8_WAIT_L(0); PG8_MMA(1, 0, At, B0); PG8_BAR; PG8_SCHED;
            PG8_STAGE(PG8_SB(1, 1), b3 + hstep, voffB);
            PG8_WAIT_V(6); PG8_BAR; PG8_MMA(1, 1, At, B1); PG8_BAR;
            }
        }
        if constexpr (ALIGN_EPI) { if (wr == 0) PG8_BAR; }
        if constexpr (!Epi::AFTER_DRAIN) { E(acc, cur, wr, wc, fr, fq); S.done(cur); }
        if (!has_next) break;
#pragma unroll
        for (int a = 0; a < 2; ++a)
#pragma unroll
            for (int b = 0; b < 2; ++b)
#pragma unroll
                for (int m = 0; m < 4; ++m)
#pragma unroll
                    for (int n = 0; n < 2; ++n) acc[a][b][m][n] = (f32x4){0.f, 0.f, 0.f, 0.f};
        cur = nxt; cA = nA; cB = nB; ++ui;
        if constexpr (ALIGN_EPI) { if (wr == 1) PG8_BAR; }
    }
    PG8_WAIT_V(0);
    if constexpr (!ALIGN_EPI) { if (wr == 0) PG8_BAR; }
    PG8_BAR;
    if constexpr (Epi::AFTER_DRAIN) { E.fused(acc, cur, wr, wc, fr, fq, lds, wid, lane); S.done(cur); }
#undef PG8_SA
#undef PG8_SB
#undef PG8_STAGE
#undef PG8_LDA
#undef PG8_LDB
#undef PG8_MMA
#undef PG8_WAIT_V
#undef PG8_WAIT_L
#undef PG8_BAR
#undef PG8_SCHED
}
}
constexpr int D = 2048, BATCH = 2, SEQ = 16384, MTOK = BATCH * SEQ, DFF = 5632, NMOD = 9, DEPTH = 4;
constexpr int NWAVES = 8, NTHREADS = NWAVES * 64;
constexpr int SSM_G = 128, SSM_K = 16, SSM_P = 64, S5_NSEG = 8, S5_LSEG = SEQ / S5_NSEG;
constexpr int GLA_H = 4, GLA_DK = 1024, GLA_DV = 2048, GLA_DKH = 256, GLA_DVH = 512, GLA_RANK = 16, GLA_C = 64, GLA_NPROJ = 6176, GLA_NPAD = 6400, GLA_NCHUNK = SEQ / GLA_C;
constexpr int DSA_G = 3, DSA_H = 8, DSA_HD = 128, DSA_QKV = 9216, DSA_OUT = 1024;
constexpr size_t MiB = (size_t)1 << 20;
constexpr size_t WS_CTL = 0, CTL_ZERO_BYTES = 64 * 1024;
constexpr size_t WS_MOD = 1 * MiB;
constexpr size_t WS_COS = 2 * MiB, WS_SIN = 6 * MiB;
constexpr size_t WS_S5E = 10 * MiB;
constexpr size_t WS_W1I = 16 * MiB, WS_W1O = 60 * MiB, WS_W2I = 82 * MiB, WS_W2O = 126 * MiB, WS_WMI = 148 * MiB, WS_WMO = 184 * MiB;
constexpr size_t WS_H = 200 * MiB;
constexpr size_t WS_B1 = 328 * MiB;
constexpr size_t WS_B2 = 904 * MiB;
constexpr size_t WS_END = 1480 * MiB;
constexpr size_t S5_YF = WS_B2, S5_YB = WS_B2 + 256 * MiB;
constexpr size_t GLA_QD = WS_B2, GLA_KL = WS_B2 + 128 * MiB, GLA_ATT = WS_B2 + 256 * MiB, GLA_DEC = WS_B2 + 288 * MiB, GLA_OD = WS_B2 + 292 * MiB;
constexpr size_t DSA_PO = WS_B2, DSA_LSE = WS_B2 + 384 * MiB;
constexpr int LDS_BYTES = 160 * 1024 - 512;
constexpr int LDS_MISC = LDS_BYTES - 64;

typedef unsigned short bf16_t;
typedef short bf16x8 __attribute__((ext_vector_type(8)));
typedef short bf16x4 __attribute__((ext_vector_type(4)));
typedef float f32x4 __attribute__((ext_vector_type(4)));
typedef float f32x16 __attribute__((ext_vector_type(16)));
typedef unsigned u32x4 __attribute__((ext_vector_type(4)));
typedef unsigned u32x2 __attribute__((ext_vector_type(2)));

typedef __bf16 bf16v2_t __attribute__((ext_vector_type(2)));
__device__ __forceinline__ unsigned pk2(float lo, float hi) { bf16v2_t v; v[0] = (__bf16)lo; v[1] = (__bf16)hi; return __builtin_bit_cast(unsigned, v); }
__device__ __forceinline__ float bf_lo(unsigned w) { return __uint_as_float(w << 16); }
__device__ __forceinline__ float bf_hi(unsigned w) { return __uint_as_float(w & 0xffff0000u); }
__device__ __forceinline__ float bf2f(bf16_t b) { return __uint_as_float(((unsigned)b) << 16); }
#define LDS_WAIT() asm volatile("s_waitcnt lgkmcnt(0)" ::: "memory")
#define VM_WAIT() asm volatile("s_waitcnt vmcnt(0)" ::: "memory")

__device__ __forceinline__ void sincos_f(float x, float& s, float& c) {
    const float k = __builtin_rintf(x * 0.636619772367581343f);
    float r = __builtin_fmaf(-k, 1.5707963705062866f, x); r = __builtin_fmaf(-k, -4.371138828673793e-08f, r); r = __builtin_fmaf(-k, -1.7151245100058819e-15f, r);
    const float r2 = r * r;
    float sp = 2.7557319e-6f; sp = __builtin_fmaf(sp, r2, -1.9841270e-4f); sp = __builtin_fmaf(sp, r2, 8.3333333e-3f); sp = __builtin_fmaf(sp, r2, -1.6666667e-1f);
    const float sr = __builtin_fmaf(r * r2, sp, r);
    float cp = -2.7557319e-7f; cp = __builtin_fmaf(cp, r2, 2.4801587e-5f); cp = __builtin_fmaf(cp, r2, -1.3888889e-3f); cp = __builtin_fmaf(cp, r2, 4.1666667e-2f);
    const float cr = __builtin_fmaf(r2 * r2, cp, __builtin_fmaf(-0.5f, r2, 1.0f));
    const int q = ((int)k) & 3;
    s = (q == 0) ? sr : (q == 1) ? cr : (q == 2) ? -sr : -cr;
    c = (q == 0) ? cr : (q == 1) ? -sr : (q == 2) ? -cr : sr;
}

struct Frame {
    LAS unsigned char* lds;
    int tid, lane, wave, G, bid;
};

__device__ __forceinline__ float shx(float v, int o, int lane) { return __int_as_float(__builtin_amdgcn_ds_bpermute((lane ^ o) << 2, __float_as_int(v))); }
__device__ __forceinline__ float wave_sum(float v, int lane) {
#pragma unroll
    for (int o = 1; o < 64; o <<= 1) v += shx(v, o, lane);
    return v;
}
template <int MODE>
__device__ __forceinline__ void transpose_item(const float* __restrict__ W, int K, int N, bf16_t* __restrict__ WT, int NH, LAS float* scr, int item, int lane) {
    const int nblk = N / 32, kb = item / nblk, nb = item % nblk, k0 = 64 * kb, n0 = 32 * nb;
    int d0 = n0;
    if (MODE == 1) { const int bj = n0 / NH, jj = n0 % NH; d0 = 256 * (jj / 128) + 128 * bj + (jj % 128); }
#pragma unroll
    for (int i = 0; i < 8; ++i) { const int kk = 8 * i + (lane >> 3), nq = 4 * (lane & 7);
        const f32x4 v = *(const f32x4*)(W + (size_t)(k0 + kk) * N + n0 + nq);
        LAS float* d = scr + kk * 33 + nq; d[0] = v.x; d[1] = v.y; d[2] = v.z; d[3] = v.w; }
    LDS_WAIT(); asm volatile("" ::: "memory");
    const int c = lane & 7;
#pragma unroll
    for (int j = 0; j < 4; ++j) { const int n = (lane >> 3) + 8 * j; const LAS float* s = scr + (8 * c) * 33 + n;
        u32x4 o; o.x = pk2(s[0 * 33], s[1 * 33]); o.y = pk2(s[2 * 33], s[3 * 33]); o.z = pk2(s[4 * 33], s[5 * 33]); o.w = pk2(s[6 * 33], s[7 * 33]);
        *(u32x4*)(WT + (size_t)(d0 + n) * K + k0 + 8 * c) = o; }
    LDS_WAIT(); asm volatile("" ::: "memory");
}
template <int MODE>
__device__ __forceinline__ void convert_matrix(const Frame& F, const float* W, int K, int N, bf16_t* WT, int NH) {
    LAS float* scr = (LAS float*)(F.lds + F.wave * 16384);
    const int gw = F.bid * NWAVES + F.wave, NGW = F.G * NWAVES, nitems = (K / 64) * (N / 32);
    for (int it = gw; it < nitems; it += NGW) transpose_item<MODE>(W, K, N, WT, NH, scr, it, F.lane);
}
__device__ __forceinline__ void zero_bf16(const Frame& F, bf16_t* p, size_t n8) {
    unsigned zz = 0u; asm volatile("" : "+v"(zz)); const u32x4 z = {zz, zz, zz, zz};
    for (size_t i = (size_t)F.bid * NTHREADS + F.tid; i < n8; i += (size_t)F.G * NTHREADS) ((u32x4*)p)[i] = z;
}
__device__ __forceinline__ void mod_phase(const Frame& F, const float* __restrict__ c, const float* __restrict__ ada_w, const float* __restrict__ ada_b, float* __restrict__ mod) {
    constexpr int NCOL = NMOD * D, UPL = NCOL / 256, NUNIT = DEPTH * UPL;
    LAS float* red = (LAS float*)F.lds;
    LAS float* sact = (LAS float*)(F.lds + 16384);
    for (int i = F.tid; i < BATCH * D; i += NTHREADS) { const float cv = c[i]; sact[i] = cv / (1.0f + __expf(-cv)); }
    __syncthreads();
    for (int u = F.bid; u < NUNIT; u += F.G) {
        const int layer = u / UPL, n0 = (u % UPL) * 256 + 4 * F.lane;
        const float* Wp = ada_w + (size_t)layer * D * NCOL + n0;
        f32x4 a0 = {0.f, 0.f, 0.f, 0.f}, a1 = {0.f, 0.f, 0.f, 0.f};
        const int kbeg = F.wave * 256;
#pragma unroll 8
        for (int k = kbeg; k < kbeg + 256; ++k) {
            const f32x4 w = *(const f32x4*)(Wp + (size_t)k * NCOL);
            a0 += w * sact[k]; a1 += w * sact[D + k];
        }
        __syncthreads();
        *(LAS f32x4*)(red + (F.wave * 2 + 0) * 256 + 4 * F.lane) = a0;
        *(LAS f32x4*)(red + (F.wave * 2 + 1) * 256 + 4 * F.lane) = a1;
        __syncthreads();
        { const int b = F.tid >> 8, col = F.tid & 255; float s = 0.f;
#pragma unroll
          for (int w = 0; w < 8; ++w) s += red[(w * 2 + b) * 256 + col];
          const int n = (u % UPL) * 256 + col;
          mod[((size_t)layer * BATCH + b) * NCOL + n] = s + ada_b[(size_t)layer * NCOL + n]; }
    }
    __syncthreads();
}
__device__ __forceinline__ void rope_phase(const Frame& F, const float* __restrict__ invf, float* __restrict__ cs, float* __restrict__ sn) {
    for (int i = F.bid * NTHREADS + F.tid; i < SEQ * 64; i += F.G * NTHREADS) {
        const int pos = i >> 6, j = i & 63;
        const float ang = (float)pos * invf[j];
        float s, c; sincos_f(ang, s, c);
        cs[i] = c; sn[i] = s;
    }
}
__device__ __forceinline__ void norm_phase(const Frame& F, const float* __restrict__ X, const float* __restrict__ g, const float* __restrict__ shift, const float* __restrict__ scale, int bstride, bf16_t* __restrict__ H, float* __restrict__ xcopy) {
    const int gw = F.bid * NWAVES + F.wave, NGW = F.G * NWAVES;
    for (int r0 = gw * 16; r0 < MTOK; r0 += NGW * 16) {
        const int b = r0 / SEQ;
        f32x4 A[8], B[8];
#pragma unroll
        for (int j = 0; j < 8; ++j) { const int c = 4 * F.lane + 256 * j; const f32x4 gg = *(const f32x4*)(g + c), sc = *(const f32x4*)(scale + (size_t)b * bstride + c);
            A[j] = gg * (sc + 1.0f); B[j] = *(const f32x4*)(shift + (size_t)b * bstride + c); }
        for (int r = r0; r < r0 + 16; ++r) {
            const f32x4* xr = (const f32x4*)(X + (size_t)r * D) + F.lane;
            f32x4 v[8]; float s = 0.f;
#pragma unroll
            for (int j = 0; j < 8; ++j) { v[j] = xr[64 * j]; s += (v[j].x * v[j].x + v[j].y * v[j].y) + (v[j].z * v[j].z + v[j].w * v[j].w); }
            if (xcopy) { f32x4* xo = (f32x4*)(xcopy + (size_t)r * D) + F.lane;
#pragma unroll
                for (int j = 0; j < 8; ++j) xo[64 * j] = v[j]; }
            const float rstd = 1.0f / sqrtf(wave_sum(s, F.lane) * (1.0f / D) + 1e-6f);
            unsigned long long* o8 = (unsigned long long*)(H + (size_t)r * D) + F.lane;
#pragma unroll
            for (int j = 0; j < 8; ++j) { const f32x4 y = v[j] * rstd * A[j] + B[j];
                o8[64 * j] = (unsigned long long)pk2(y.x, y.y) | ((unsigned long long)pk2(y.z, y.w) << 32); }
        }
    }
}
template <int PASS>
__device__ __forceinline__ void s5_scan(const Frame& F, int jl, const bf16_t* __restrict__ U, const float* __restrict__ lam_re, const float* __restrict__ lam_im, const float* __restrict__ log_dt,
                                        const float* __restrict__ b_re, const float* __restrict__ b_im, const float* __restrict__ c_re, const float* __restrict__ c_im,
                                        float* __restrict__ E, bf16_t* __restrict__ YF, bf16_t* __restrict__ YB) {
    const int lane = F.lane, c = lane & 31, h = lane >> 5, i15 = lane & 15, kq = lane >> 4;
    const int gw = F.bid * NWAVES + F.wave, NGW = F.G * NWAVES;
    constexpr int NS = (PASS == 1) ? S5_NSEG - 1 : S5_NSEG;
    constexpr int NIT = SSM_G * 2 * NS;
    constexpr int TP = 272;
    LAS unsigned char* tile = F.lds + F.wave * (32 * TP);
    for (int it = gw; it < NIT; it += NGW) {
        const int rest_ = it >> 3, seg = rest_ % NS, dir = (rest_ / NS) & 1, g = 8 * (rest_ / (NS * 2)) + (it & 7);
        const int pb = (jl * 2 + dir) * SSM_G + g;
        const float dt = expf(log_dt[pb]);
        float ar[2], ai[2], Lr[2], Li[2], fr[2], fi[2];
#pragma unroll
        for (int s = 0; s < 2; ++s) {
            const int p = 2 * c + s;
            const float lr = lam_re[pb * SSM_P + p], li = lam_im[pb * SSM_P + p], zr = lr * dt, zi = li * dt;
            const float em1 = expm1f(zr), mag = em1 + 1.0f; float sn, cs, sh, ch; sincos_f(zi, sn, cs); sincos_f(0.5f * zi, sh, ch);
            const float a_r = mag * cs, a_i = mag * sn, am1 = em1 * cs - 2.0f * sh * sh, den = lr * lr + li * li;
            fr[s] = (am1 * lr + a_i * li) / den; fi[s] = (a_i * lr - am1 * li) / den;
            ar[s] = a_r; ai[s] = a_i;
            const float magL = expf(zr * (float)S5_LSEG); sincos_f(zi * (float)S5_LSEG, sn, cs);
            Lr[s] = magL * cs; Li[s] = magL * sn;
        }
        bf16x8 Bf[4];
#pragma unroll
        for (int s = 0; s < 2; ++s) {
            const int p = 2 * c + s;
            const float* pr = b_re + ((size_t)pb * SSM_P + p) * SSM_K + 8 * h; const float* pi = b_im + ((size_t)pb * SSM_P + p) * SSM_K + 8 * h;
            const f32x4 r0 = *(const f32x4*)pr, r1 = *(const f32x4*)(pr + 4), i0 = *(const f32x4*)pi, i1 = *(const f32x4*)(pi + 4);
            float vr[8], vi[8];
#pragma unroll
            for (int j = 0; j < 4; ++j) { vr[j] = fr[s] * r0[j] - fi[s] * i0[j]; vr[4 + j] = fr[s] * r1[j] - fi[s] * i1[j];
                                          vi[j] = fr[s] * i0[j] + fi[s] * r0[j]; vi[4 + j] = fr[s] * i1[j] + fi[s] * r1[j]; }
            u32x4 wr_, wi_; wr_.x = pk2(vr[0], vr[1]); wr_.y = pk2(vr[2], vr[3]); wr_.z = pk2(vr[4], vr[5]); wr_.w = pk2(vr[6], vr[7]);
            wi_.x = pk2(vi[0], vi[1]); wi_.y = pk2(vi[2], vi[3]); wi_.z = pk2(vi[4], vi[5]); wi_.w = pk2(vi[6], vi[7]);
            Bf[s] = __builtin_bit_cast(bf16x8, wr_); Bf[2 + s] = __builtin_bit_cast(bf16x8, wi_);
        }
        bf16x8 Cf[4];
        if (PASS == 2) {
#pragma unroll
            for (int ks = 0; ks < 4; ++ks) {
                const float* src = ((ks >> 1) ? c_im : c_re) + ((size_t)pb * SSM_K + i15) * SSM_P + 32 * (ks & 1) + 8 * kq;
                const float sg = (ks >> 1) ? -1.0f : 1.0f;
                const f32x4 v0 = *(const f32x4*)src * sg, v1 = *(const f32x4*)(src + 4) * sg;
                u32x4 w; w.x = pk2(v0[0], v0[1]); w.y = pk2(v0[2], v0[3]); w.z = pk2(v1[0], v1[1]); w.w = pk2(v1[2], v1[3]);
                Cf[ks] = __builtin_bit_cast(bf16x8, w);
            }
        }
        float sr[2] = {0.f, 0.f}, si[2] = {0.f, 0.f};
        if (PASS == 2) {
            for (int i = 0; i < seg; ++i) {
                const f32x4 e = *(const f32x4*)(E + ((((size_t)(dir * SSM_G + g) * S5_NSEG + i) * 2 + h) * SSM_P + 2 * c) * 2);
                const float n0r = Lr[0] * sr[0] - Li[0] * si[0] + e[0], n0i = Lr[0] * si[0] + Li[0] * sr[0] + e[1];
                const float n1r = Lr[1] * sr[1] - Li[1] * si[1] + e[2], n1i = Lr[1] * si[1] + Li[1] * sr[1] + e[3];
                sr[0] = n0r; si[0] = n0i; sr[1] = n1r; si[1] = n1i;
            }
        }
        const int rr = lane & 31, hrow = (rr >> 2) & 1, tau_a = 4 * (rr >> 3) + (rr & 3);
        const bf16_t* Ucol = U + (size_t)hrow * SEQ * D + 16 * g + 8 * h;
        const int nbase = seg * S5_LSEG;
        bf16_t* Y = dir ? YB : YF;
#define S5_TPOS(n) (dir ? (SEQ - 1 - (n)) : (n))
        constexpr int NW = S5_LSEG / 16, PF = 4;
        bf16x8 Aq[PF];
#pragma unroll
        for (int i = 0; i < PF; ++i) Aq[i] = *(const bf16x8*)(Ucol + (size_t)S5_TPOS(nbase + 16 * i + tau_a) * D);
        for (int w4 = 0; w4 < NW; w4 += PF) {
#pragma unroll
        for (int wi = 0; wi < PF; ++wi) {
            const int w = w4 + wi;
            const bf16x8 Acur = Aq[wi];
            const int wn = (w + PF < NW) ? w + PF : NW - 1;
            Aq[wi] = *(const bf16x8*)(Ucol + (size_t)S5_TPOS(nbase + 16 * wn + tau_a) * D);
            f32x16 acc[4];
#pragma unroll
            for (int nb = 0; nb < 4; ++nb) { f32x16 z;
#pragma unroll
                for (int q = 0; q < 16; ++q) z[q] = 0.f;
                acc[nb] = __builtin_amdgcn_mfma_f32_32x32x16_bf16(Acur, Bf[nb], z, 0, 0, 0); }
#pragma unroll
            for (int tau = 0; tau < 16; ++tau) {
                const float n0r = ar[0] * sr[0] - ai[0] * si[0] + acc[0][tau], n0i = ar[0] * si[0] + ai[0] * sr[0] + acc[2][tau];
                const float n1r = ar[1] * sr[1] - ai[1] * si[1] + acc[1][tau], n1i = ar[1] * si[1] + ai[1] * sr[1] + acc[3][tau];
                sr[0] = n0r; si[0] = n0i; sr[1] = n1r; si[1] = n1i;
                if (PASS == 2) {
                    *(LAS unsigned*)(tile + (16 * h + tau) * TP + 4 * c) = pk2(n0r, n1r);
                    *(LAS unsigned*)(tile + (16 * h + tau) * TP + 128 + 4 * c) = pk2(n0i, n1i);
                }
            }
            if (PASS == 2) {
                LDS_WAIT();
#pragma unroll
                for (int mb = 0; mb < 2; ++mb) {
                    f32x4 y = {0.f, 0.f, 0.f, 0.f};
#pragma unroll
                    for (int ks = 0; ks < 4; ++ks) { const bf16x8 Af = *(const LAS bf16x8*)(tile + (16 * mb + i15) * TP + (32 * ks + 8 * kq) * 2);
                        y = __builtin_amdgcn_mfma_f32_16x16x32_bf16(Cf[ks], Af, y, 0, 0, 0); }
                    { const int t = S5_TPOS(nbase + 16 * w + i15); u32x2 yw; yw.x = pk2(y[0], y[1]); yw.y = pk2(y[2], y[3]);
                      *(u32x2*)(Y + ((size_t)mb * SEQ + t) * D + 16 * g + 4 * kq) = yw; }
                }
            }
        } }
        if (PASS == 1) {
            f32x4 e = {sr[0], si[0], sr[1], si[1]};
            *(f32x4*)(E + ((((size_t)(dir * SSM_G + g) * S5_NSEG + seg) * 2 + h) * SSM_P + 2 * c) * 2) = e;
        }
    }
}
#undef S5_TPOS
__device__ __forceinline__ unsigned lds_addr0(const LAS unsigned char* p) { return (unsigned)(unsigned long long)p; }
__device__ __forceinline__ void s5_pass1(const Frame& F, int jl, const bf16_t* __restrict__ U, const float* __restrict__ lam_re, const float* __restrict__ lam_im, const float* __restrict__ log_dt,
                                         const float* __restrict__ b_re, const float* __restrict__ b_im, float* __restrict__ E) {
    const int tid = F.tid, lane = F.lane, c = lane & 31, h = lane >> 5, w = F.wave;
    constexpr int WP = 528;
    LAS unsigned char* Wt = F.lds;
    for (int pair0 = F.bid; pair0 < SSM_G * 2; pair0 += F.G) {
        const int pair = (F.G == 256) ? ((pair0 & 7) * 32 + (pair0 >> 3)) : pair0;
        const int dir = pair & 1, g = pair >> 1, pb = (jl * 2 + dir) * SSM_G + g;
        const float dt = expf(log_dt[pb]);
        __syncthreads();
        { const int col = tid & 127, tq = tid >> 7, nb = col >> 5, p = 2 * (col & 31) + (nb & 1), part = nb >> 1;
          const float lr = lam_re[pb * SSM_P + p], li = lam_im[pb * SSM_P + p], zr = lr * dt, zi = li * dt;
          const float em1 = expm1f(zr), mag = em1 + 1.0f; float sn, cs, sh, ch; sincos_f(zi, sn, cs); sincos_f(0.5f * zi, sh, ch);
          const float a_i = mag * sn, am1 = em1 * cs - 2.0f * sh * sh, den = lr * lr + li * li;
          const float fr = (am1 * lr + a_i * li) / den, fi = (a_i * lr - am1 * li) / den;
          const float* pr = b_re + ((size_t)pb * SSM_P + p) * SSM_K; const float* pi = b_im + ((size_t)pb * SSM_P + p) * SSM_K;
          f32x4 br[4], bi[4];
#pragma unroll
          for (int q = 0; q < 4; ++q) { br[q] = *(const f32x4*)(pr + 4 * q); bi[q] = *(const f32x4*)(pi + 4 * q); }
#pragma unroll
          for (int tt = 0; tt < 4; ++tt) { const int tau = 4 * tq + tt; const float pw = (float)(15 - tau);
              const float mg = expf(zr * pw); float s2, c2; sincos_f(zi * pw, s2, c2);
              const float pr_ = mg * c2, pi_ = mg * s2, cr = pr_ * fr - pi_ * fi, ci = pr_ * fi + pi_ * fr;
              unsigned wv[8];
#pragma unroll
              for (int q = 0; q < 4; ++q) { float v[4];
#pragma unroll
                  for (int e = 0; e < 4; ++e) v[e] = part ? (cr * bi[q][e] + ci * br[q][e]) : (cr * br[q][e] - ci * bi[q][e]);
                  wv[2 * q] = pk2(v[0], v[1]); wv[2 * q + 1] = pk2(v[2], v[3]); }
              LAS u32x4* dst = (LAS u32x4*)(Wt + col * WP + tau * 32);
              dst[0] = (u32x4){wv[0], wv[1], wv[2], wv[3]}; dst[1] = (u32x4){wv[4], wv[5], wv[6], wv[7]}; } }
        __syncthreads();
        if (w < S5_NSEG - 1) {
            const int seg = w;
            float L16r[2], L16i[2], sr[2] = {0.f, 0.f}, si[2] = {0.f, 0.f};
#pragma unroll
            for (int s = 0; s < 2; ++s) { const int p = 2 * c + s; const float zr = lam_re[pb * SSM_P + p] * dt, zi = lam_im[pb * SSM_P + p] * dt;
                const float mg = expf(16.0f * zr); float sn, cs; sincos_f(16.0f * zi, sn, cs); L16r[s] = mg * cs; L16i[s] = mg * sn; }
            const int rr = lane & 31, hrow = (rr >> 2) & 1, om = 4 * (rr >> 3) + (rr & 3);
            const bf16_t* Ucol = U + (size_t)hrow * SEQ * D + 16 * g + 8 * h;
            for (int wg = 0; wg < S5_LSEG / 256; ++wg) {
                const int n0 = seg * S5_LSEG + (16 * wg + om) * 16;
                f32x16 acc[4];
#pragma unroll
                for (int nb = 0; nb < 4; ++nb)
#pragma unroll
                    for (int q = 0; q < 16; ++q) acc[nb][q] = 0.f;
                unsigned wb = lds_addr0(Wt + c * WP + 16 * h); asm volatile("" : "+v"(wb));
#pragma unroll
                for (int th = 0; th < 2; ++th) {
                    bf16x8 Aq[8];
#pragma unroll
                    for (int t8 = 0; t8 < 8; ++t8) { const int n = n0 + 8 * th + t8, t = dir ? (SEQ - 1 - n) : n; Aq[t8] = *(const bf16x8*)(Ucol + (size_t)t * D); }
#pragma unroll
                    for (int t8 = 0; t8 < 8; ++t8)
#pragma unroll
                        for (int nb = 0; nb < 4; ++nb) { const bf16x8 Bq = *(const LAS bf16x8*)(size_t)(wb + (32 * nb) * WP + (8 * th + t8) * 32);
                            acc[nb] = __builtin_amdgcn_mfma_f32_32x32x16_bf16(Aq[t8], Bq, acc[nb], 0, 0, 0); }
                }
#pragma unroll
                for (int o = 0; o < 16; ++o) {
                    const float n0r = L16r[0] * sr[0] - L16i[0] * si[0] + acc[0][o], n0i = L16r[0] * si[0] + L16i[0] * sr[0] + acc[2][o];
                    const float n1r = L16r[1] * sr[1] - L16i[1] * si[1] + acc[1][o], n1i = L16r[1] * si[1] + L16i[1] * sr[1] + acc[3][o];
                    sr[0] = n0r; si[0] = n0i; sr[1] = n1r; si[1] = n1i; }
            }
            f32x4 e = {sr[0], si[0], sr[1], si[1]};
            *(f32x4*)(E + ((((size_t)(dir * SSM_G + g) * S5_NSEG + seg) * 2 + h) * SSM_P + 2 * c) * 2) = e;
        }
    }
    __syncthreads();
}
__device__ __forceinline__ void s5_post(const Frame& F, const bf16_t* __restrict__ YF, const bf16_t* __restrict__ YB, const bf16_t* __restrict__ U, const float* __restrict__ dv, bf16_t* __restrict__ O) {
    const size_t n8 = (size_t)MTOK * D / 8;
    for (size_t i = (size_t)F.bid * NTHREADS + F.tid; i < n8; i += (size_t)F.G * NTHREADS) {
        const int col = (int)(i % (D / 8)) * 8;
        const u32x4 aw = *(const u32x4*)(YF + i * 8), bw = *(const u32x4*)(YB + i * 8), uw = *(const u32x4*)(U + i * 8);
        const f32x4 d0 = *(const f32x4*)(dv + col), d1 = *(const f32x4*)(dv + col + 4);
        float y[8];
        y[0] = bf_lo(aw.x) + bf_lo(bw.x) + d0[0] * bf_lo(uw.x); y[1] = bf_hi(aw.x) + bf_hi(bw.x) + d0[1] * bf_hi(uw.x); y[2] = bf_lo(aw.y) + bf_lo(bw.y) + d0[2] * bf_lo(uw.y); y[3] = bf_hi(aw.y) + bf_hi(bw.y) + d0[3] * bf_hi(uw.y);
        y[4] = bf_lo(aw.z) + bf_lo(bw.z) + d1[0] * bf_lo(uw.z); y[5] = bf_hi(aw.z) + bf_hi(bw.z) + d1[1] * bf_hi(uw.z); y[6] = bf_lo(aw.w) + bf_lo(bw.w) + d1[2] * bf_lo(uw.w); y[7] = bf_hi(aw.w) + bf_hi(bw.w) + d1[3] * bf_hi(uw.w);
#pragma unroll
        for (int j = 0; j < 8; ++j) { const float z = 0.7978845608028654f * (y[j] + 0.044715f * y[j] * y[j] * y[j]); y[j] = y[j] * __builtin_amdgcn_rcpf(1.0f + __expf(-2.0f * z)); }
        u32x4 o; o.x = pk2(y[0], y[1]); o.y = pk2(y[2], y[3]); o.z = pk2(y[4], y[5]); o.w = pk2(y[6], y[7]);
        *(u32x4*)(O + i * 8) = o;
    }
}
__device__ __forceinline__ bf16x8 tr_read2(unsigned a0, unsigned a1) {
    bf16x4 r0, r1;
    asm volatile("ds_read_b64_tr_b16 %0, %2\n\tds_read_b64_tr_b16 %1, %3\n\ts_waitcnt lgkmcnt(0)" : "=&v"(r0), "=&v"(r1) : "v"(a0), "v"(a1) : "memory");
    bf16x8 o; o[0] = r0[0]; o[1] = r0[1]; o[2] = r0[2]; o[3] = r0[3]; o[4] = r1[0]; o[5] = r1[1]; o[6] = r1[2]; o[7] = r1[3]; return o;
}
__device__ __forceinline__ unsigned lds_addr(const LAS unsigned char* p) { return (unsigned)(unsigned long long)p; }
constexpr int GLA_QP = 528;
constexpr int GLA_AP = 144;
constexpr int GLA_VP = 272;

__device__ __forceinline__ void gla_a(const Frame& F, int jb, const bf16_t* __restrict__ PROJ, const float* __restrict__ w_gate, const float* __restrict__ b_gate,
                                      bf16_t* __restrict__ QD, bf16_t* __restrict__ KL, bf16_t* __restrict__ ATT, float* __restrict__ DEC) {
    LAS float* Gt = (LAS float*)F.lds;
    LAS float* Tt = (LAS float*)(F.lds + 4096);
    LAS float* BLt = (LAS float*)(F.lds + 4096 + 2048);
    LAS unsigned char* QDt = F.lds + 8192;
    LAS unsigned char* KDt = F.lds + 8192 + 64 * GLA_QP;
    constexpr int GLA_BP = 1040;
    LAS unsigned char* Bt = F.lds + 8192 + 128 * GLA_QP;
    const int tid = F.tid, lane = F.lane, w = F.wave, i15 = lane & 15, kq = lane >> 4;
    const int kk = tid & 255, half = tid >> 8;
    for (int item = F.bid; item < 16 * GLA_NCHUNK; item += F.G) {
        const int c = item & (GLA_NCHUNK - 1), seq = item >> 8, dir = seq & 1, hh = (seq >> 1) & 3, b = seq >> 3;
        const int n0 = GLA_C * c;
        u32x4 rq[4], rk[4];
#pragma unroll
        for (int i = 0; i < 4; ++i) { const int q_ = tid + 512 * i, n = q_ >> 5, ch = q_ & 31, nn = n0 + n, t = dir ? (SEQ - 1 - nn) : nn;
            const bf16_t* rowp = PROJ + (size_t)(b * SEQ + t) * GLA_NPAD + GLA_DKH * hh + 8 * ch; rq[i] = *(const u32x4*)rowp; rk[i] = *(const u32x4*)(rowp + GLA_DK); }
        __syncthreads();
        if (tid < 128) { const int n = tid >> 1, h8 = tid & 1, nn = n0 + n, t = dir ? (SEQ - 1 - nn) : nn;
            const u32x4 wv = *(const u32x4*)(PROJ + (size_t)(b * SEQ + t) * GLA_NPAD + 6144 + 16 * dir + 8 * h8);
            LAS float* gp = Gt + n * 16 + 8 * h8;
            gp[0] = bf_lo(wv.x); gp[1] = bf_hi(wv.x); gp[2] = bf_lo(wv.y); gp[3] = bf_hi(wv.y); gp[4] = bf_lo(wv.z); gp[5] = bf_hi(wv.z); gp[6] = bf_lo(wv.w); gp[7] = bf_hi(wv.w); }
        float wg[16];
#pragma unroll
        for (int r = 0; r < 16; ++r) wg[r] = w_gate[((size_t)(jb * 2 + dir) * GLA_RANK + r) * GLA_DK + GLA_DKH * hh + kk];
        const float bias = b_gate[(size_t)(jb * 2 + dir) * GLA_DK + GLA_DKH * hh + kk];
        __syncthreads();
        float bc[32]; float run = 0.f;
#pragma unroll
        for (int i = 0; i < 32; ++i) { const LAS f32x4* gr = (const LAS f32x4*)(Gt + (32 * half + i) * 16);
            const f32x4 g0 = gr[0], g1 = gr[1], g2 = gr[2], g3 = gr[3];
            float gl = bias;
#pragma unroll
            for (int r = 0; r < 4; ++r) gl += g0[r] * wg[r] + g1[r] * wg[4 + r] + g2[r] * wg[8 + r] + g3[r] * wg[12 + r];
            const float ls = fminf(gl, 0.f) - __logf(1.0f + __expf(-fabsf(gl)));
            run += ls * (1.0f / 16.0f); bc[i] = run; }
        Tt[half * 256 + kk] = run;
        __syncthreads();
        const float t0 = Tt[kk], blast = t0 + Tt[256 + kk];
        if (half) {
#pragma unroll
            for (int i = 0; i < 32; ++i) bc[i] += t0; }
#pragma unroll
        for (int i = 0; i < 32; ++i) *(LAS float*)(Bt + (32 * half + i) * GLA_BP + kk * 4) = bc[i];
        if (half == 0) { BLt[kk] = blast; DEC[((size_t)seq * GLA_NCHUNK + c) * GLA_DKH + kk] = __expf(blast); }
        __syncthreads();
        const size_t grow = (size_t)seq * SEQ + n0;
#pragma unroll
        for (int i = 0; i < 4; ++i) { const int q_ = tid + 512 * i, n = q_ >> 5, ch = q_ & 31;
            const f32x4 b0 = *(const LAS f32x4*)(Bt + n * GLA_BP + ch * 32), b1 = *(const LAS f32x4*)(Bt + n * GLA_BP + ch * 32 + 16);
            const f32x4 l0 = *(const LAS f32x4*)(BLt + 8 * ch), l1 = *(const LAS f32x4*)(BLt + 8 * ch + 4);
            const unsigned qw[4] = {rq[i].x, rq[i].y, rq[i].z, rq[i].w}, kw[4] = {rk[i].x, rk[i].y, rk[i].z, rk[i].w};
            unsigned oq[4], okd[4], okl[4];
#pragma unroll
            for (int e = 0; e < 4; ++e) { const float ba = e < 2 ? b0[2 * e] : b1[2 * e - 4], bb = e < 2 ? b0[2 * e + 1] : b1[2 * e - 3], la = e < 2 ? l0[2 * e] : l1[2 * e - 4], lb = e < 2 ? l0[2 * e + 1] : l1[2 * e - 3];
                const float qa = bf_lo(qw[e]), qb = bf_hi(qw[e]), ka = bf_lo(kw[e]), kb = bf_hi(kw[e]);
                oq[e] = pk2(qa * 0.0625f * __expf(ba), qb * 0.0625f * __expf(bb)); okd[e] = pk2(ka * __expf(-ba), kb * __expf(-bb)); okl[e] = pk2(ka * __expf(la - ba), kb * __expf(lb - bb)); }
            const u32x4 vq = {oq[0], oq[1], oq[2], oq[3]}, vkd = {okd[0], okd[1], okd[2], okd[3]}, vkl = {okl[0], okl[1], okl[2], okl[3]};
            *(LAS u32x4*)(QDt + n * GLA_QP + ch * 16) = vq; *(LAS u32x4*)(KDt + n * GLA_QP + ch * 16) = vkd;
            *(u32x4*)(QD + (grow + n) * GLA_DKH + 8 * ch) = vq; *(u32x4*)(KL + (grow + n) * GLA_DKH + 8 * ch) = vkl; }
        __syncthreads();
        const int sb = w >> 1;
        f32x4 acc[2] = {{0.f, 0.f, 0.f, 0.f}, {0.f, 0.f, 0.f, 0.f}};
#pragma unroll
        for (int ks = 0; ks < 8; ++ks) { const bf16x8 Af = *(const LAS bf16x8*)(KDt + (16 * sb + i15) * GLA_QP + (32 * ks + 8 * kq) * 2);
#pragma unroll
            for (int j = 0; j < 2; ++j) { const int nb = 2 * (w & 1) + j; const bf16x8 Bq = *(const LAS bf16x8*)(QDt + (16 * nb + i15) * GLA_QP + (32 * ks + 8 * kq) * 2);
                acc[j] = __builtin_amdgcn_mfma_f32_16x16x32_bf16(Af, Bq, acc[j], 0, 0, 0); } }
#pragma unroll
        for (int j = 0; j < 2; ++j) { const int n = 16 * (2 * (w & 1) + j) + i15, s0 = 16 * sb + 4 * kq;
            float v[4];
#pragma unroll
            for (int e = 0; e < 4; ++e) { const int s = s0 + e; const bool keep = dir ? (s < n) : (s <= n); v[e] = keep ? acc[j][e] : 0.f; }
            u32x2 o; o.x = pk2(v[0], v[1]); o.y = pk2(v[2], v[3]);
            *(u32x2*)(ATT + ((size_t)item * GLA_C + n) * GLA_C + s0) = o; }
    }
    __syncthreads();
}

constexpr int GLA_NSEG = 4, GLA_SEGC = GLA_NCHUNK / GLA_NSEG;
#define TR_ISSUE(r0, r1, a0, a1) asm volatile("ds_read_b64_tr_b16 %0, %2\n\tds_read_b64_tr_b16 %1, %3" : "=&v"(r0), "=&v"(r1) : "v"(a0), "v"(a1) : "memory")
__device__ __forceinline__ bf16x8 tr_join(bf16x4 r0, bf16x4 r1) { bf16x8 o; o[0] = r0[0]; o[1] = r0[1]; o[2] = r0[2]; o[3] = r0[3]; o[4] = r1[0]; o[5] = r1[1]; o[6] = r1[2]; o[7] = r1[3]; return o; }
template <int PASS>
__device__ __forceinline__ void gla_b(const Frame& F, const bf16_t* __restrict__ PROJ, const bf16_t* __restrict__ QD, const bf16_t* __restrict__ KL, const bf16_t* __restrict__ ATT,
                                      const float* __restrict__ DEC, bf16_t* __restrict__ OD, float* __restrict__ SLOC) {
    const int s64 = ((F.bid >> 5) << 3) + (F.bid & 7), seg = s64 & 3;
    if (F.bid >= 256 || (PASS == 1 && seg == GLA_NSEG - 1)) return;
    LAS unsigned char* QDt = F.lds;
    LAS unsigned char* KLt = F.lds + 64 * GLA_QP;
    LAS unsigned char* ATt = F.lds + 128 * GLA_QP;
    LAS unsigned char* Vt = ATt + 64 * GLA_AP;
    LAS unsigned char* DCt = Vt + 64 * GLA_VP;
    const int tid = F.tid, lane = F.lane, w = F.wave, i15 = lane & 15, kq = lane >> 4, qq = (lane & 15) >> 2, p = lane & 3;
    const int qv = (F.bid >> 3) & 3, seq = s64 >> 2, dir = seq & 1, hh = (seq >> 1) & 3, b = seq >> 3;
    f32x4* sl = (f32x4*)SLOC + ((((size_t)(seq * GLA_NSEG + seg) * 4 + qv) * NWAVES + w) * 32) * 64 + lane;
    f32x4 S[16];
#pragma unroll
    for (int i = 0; i < 16; ++i) S[i] = (f32x4){0.f, 0.f, 0.f, 0.f};
    f32x4 Pd[PASS == 1 ? 16 : 1];
    if (PASS == 1) {
#pragma unroll
        for (int i = 0; i < 16; ++i) Pd[i] = (f32x4){1.f, 1.f, 1.f, 1.f};
    } else {
        for (int j = 0; j < seg; ++j) { const f32x4* sj = (const f32x4*)SLOC + ((((size_t)(seq * GLA_NSEG + j) * 4 + qv) * NWAVES + w) * 32) * 64 + lane;
#pragma unroll
            for (int i = 0; i < 16; ++i) S[i] = sj[(16 + i) * 64] * S[i] + sj[i * 64]; }
    }
    u32x4 rq[PASS == 2 ? 4 : 1], rk[4], ra, rv[2]; f32x4 rd = {0.f, 0.f, 0.f, 0.f};
#define GLA_B_LOAD(cc) do { \
        const u32x4* ksrc = (const u32x4*)(KL + ((size_t)seq * SEQ + (size_t)GLA_C * (cc)) * GLA_DKH); \
        _Pragma("unroll") for (int i = 0; i < 4; ++i) rk[i] = ksrc[tid + 512 * i]; \
        if (PASS == 2) { const u32x4* qsrc = (const u32x4*)(QD + ((size_t)seq * SEQ + (size_t)GLA_C * (cc)) * GLA_DKH); \
            _Pragma("unroll") for (int i = 0; i < 4; ++i) rq[i] = qsrc[tid + 512 * i]; \
            ra = ((const u32x4*)(ATT + ((size_t)seq * GLA_NCHUNK + (cc)) * (GLA_C * GLA_C)))[tid]; } \
        _Pragma("unroll") for (int i = 0; i < 2; ++i) { const int q_ = tid + 512 * i, n_ = q_ >> 4, ch_ = q_ & 15, nn_ = GLA_C * (cc) + n_, t_ = dir ? (SEQ - 1 - nn_) : nn_; \
            rv[i] = *(const u32x4*)(PROJ + (size_t)(b * SEQ + t_) * GLA_NPAD + 2048 + GLA_DVH * hh + 128 * qv + 8 * ch_); } \
        if (tid < 64) rd = *(const f32x4*)(DEC + ((size_t)seq * GLA_NCHUNK + (cc)) * GLA_DKH + 4 * tid); } while (0)
    const int c0 = seg * GLA_SEGC;
    GLA_B_LOAD(c0);
    for (int c = c0; c < c0 + GLA_SEGC; ++c) {
        __syncthreads();
#pragma unroll
        for (int i = 0; i < 4; ++i) { const int q_ = tid + 512 * i, row = q_ >> 5, ch = q_ & 31;
            if (PASS == 2) *(LAS u32x4*)(QDt + row * GLA_QP + ch * 16) = rq[i];
            *(LAS u32x4*)(KLt + row * GLA_QP + ch * 16) = rk[i]; }
        if (PASS == 2) *(LAS u32x4*)(ATt + (tid >> 3) * GLA_AP + (tid & 7) * 16) = ra;
#pragma unroll
        for (int i = 0; i < 2; ++i) { const int q_ = tid + 512 * i; *(LAS u32x4*)(Vt + (q_ >> 4) * GLA_VP + (q_ & 15) * 16) = rv[i]; }
        if (tid < 64) *(LAS f32x4*)(DCt + 16 * tid) = rd;
        __syncthreads();
        if (c + 1 < c0 + GLA_SEGC) GLA_B_LOAD(c + 1);
        unsigned vtb = lds_addr(Vt + (8 * kq + qq) * GLA_VP + (16 * w + 4 * p) * 2), klb = lds_addr(KLt + (8 * kq + qq) * GLA_QP + (4 * p) * 2);
        asm volatile("" : "+v"(vtb), "+v"(klb));
        bf16x8 Vf[2];
        { bf16x4 t0, t1, t2, t3; const unsigned a0 = vtb, a1 = vtb + 4 * GLA_VP, a2 = vtb + 32 * GLA_VP, a3 = vtb + 36 * GLA_VP;
          asm volatile("ds_read_b64_tr_b16 %0, %4\n\tds_read_b64_tr_b16 %1, %5\n\tds_read_b64_tr_b16 %2, %6\n\tds_read_b64_tr_b16 %3, %7\n\ts_waitcnt lgkmcnt(0)"
                       : "=&v"(t0), "=&v"(t1), "=&v"(t2), "=&v"(t3) : "v"(a0), "v"(a1), "v"(a2), "v"(a3) : "memory");
          Vf[0] = tr_join(t0, t1); Vf[1] = tr_join(t2, t3); }
        if (PASS == 2) {
            f32x4 o[4];
#pragma unroll
            for (int rb = 0; rb < 4; ++rb) { o[rb] = (f32x4){0.f, 0.f, 0.f, 0.f};
#pragma unroll
                for (int ks = 0; ks < 2; ++ks) { const bf16x8 Af = *(const LAS bf16x8*)(ATt + (16 * rb + i15) * GLA_AP + (32 * ks + 8 * kq) * 2);
                    o[rb] = __builtin_amdgcn_mfma_f32_16x16x32_bf16(Vf[ks], Af, o[rb], 0, 0, 0); } }
#pragma unroll
            for (int kb2 = 0; kb2 < 8; ++kb2) {
                u32x4 bw; bw.x = pk2(S[2 * kb2][0], S[2 * kb2][1]); bw.y = pk2(S[2 * kb2][2], S[2 * kb2][3]); bw.z = pk2(S[2 * kb2 + 1][0], S[2 * kb2 + 1][1]); bw.w = pk2(S[2 * kb2 + 1][2], S[2 * kb2 + 1][3]);
                const bf16x8 Bs = __builtin_bit_cast(bf16x8, bw);
#pragma unroll
                for (int rb = 0; rb < 4; ++rb) { const LAS unsigned char* ap = QDt + (16 * rb + i15) * GLA_QP + (32 * kb2 + 4 * kq) * 2;
                    const u32x2 lo = *(const LAS u32x2*)ap, hi = *(const LAS u32x2*)(ap + 32);
                    u32x4 aw; aw.x = lo.x; aw.y = lo.y; aw.z = hi.x; aw.w = hi.y;
                    o[rb] = __builtin_amdgcn_mfma_f32_16x16x32_bf16(Bs, __builtin_bit_cast(bf16x8, aw), o[rb], 0, 0, 0); } }
#pragma unroll
            for (int rb = 0; rb < 4; ++rb) { const int nn = GLA_C * c + 16 * rb + i15, t = dir ? (SEQ - 1 - nn) : nn;
                u32x2 ow; ow.x = pk2(o[rb][0], o[rb][1]); ow.y = pk2(o[rb][2], o[rb][3]);
                *(u32x2*)(OD + ((size_t)dir * MTOK + (size_t)b * SEQ + t) * GLA_DV + GLA_DVH * hh + 128 * qv + 16 * w + 4 * kq) = ow; }
        }
#pragma unroll
        for (int kb = 0; kb < 16; kb += 2) {
            bf16x4 t0, t1, t2, t3, t4, t5, t6, t7;
            const unsigned b0 = klb + (16 * kb) * 2, b1 = b0 + 32 * GLA_QP, b2 = b0 + 32, b3 = b2 + 32 * GLA_QP;
            const f32x4 d0 = *(const LAS f32x4*)(DCt + (16 * kb + 4 * kq) * 4), d1 = *(const LAS f32x4*)(DCt + (16 * (kb + 1) + 4 * kq) * 4);
            asm volatile("ds_read_b64_tr_b16 %0, %8\n\tds_read_b64_tr_b16 %1, %8 offset:2112\n\tds_read_b64_tr_b16 %2, %9\n\tds_read_b64_tr_b16 %3, %9 offset:2112\n\t"
                         "ds_read_b64_tr_b16 %4, %10\n\tds_read_b64_tr_b16 %5, %10 offset:2112\n\tds_read_b64_tr_b16 %6, %11\n\tds_read_b64_tr_b16 %7, %11 offset:2112\n\ts_waitcnt lgkmcnt(0)"
                         : "=&v"(t0), "=&v"(t1), "=&v"(t2), "=&v"(t3), "=&v"(t4), "=&v"(t5), "=&v"(t6), "=&v"(t7) : "v"(b0), "v"(b1), "v"(b2), "v"(b3) : "memory");
            static_assert(4 * GLA_QP == 2112, "offset literal in the asm above");
            S[kb] = S[kb] * d0; S[kb + 1] = S[kb + 1] * d1;
            if (PASS == 1) { Pd[kb] = Pd[kb] * d0; Pd[kb + 1] = Pd[kb + 1] * d1; }
            S[kb] = __builtin_amdgcn_mfma_f32_16x16x32_bf16(tr_join(t0, t1), Vf[0], S[kb], 0, 0, 0); S[kb] = __builtin_amdgcn_mfma_f32_16x16x32_bf16(tr_join(t2, t3), Vf[1], S[kb], 0, 0, 0);
            S[kb + 1] = __builtin_amdgcn_mfma_f32_16x16x32_bf16(tr_join(t4, t5), Vf[0], S[kb + 1], 0, 0, 0); S[kb + 1] = __builtin_amdgcn_mfma_f32_16x16x32_bf16(tr_join(t6, t7), Vf[1], S[kb + 1], 0, 0, 0);
        }
    }
    if (PASS == 1) {
#pragma unroll
        for (int i = 0; i < 16; ++i) { sl[i * 64] = S[i]; sl[(16 + i) * 64] = Pd[i]; }
    }
#undef GLA_B_LOAD
}

__device__ __forceinline__ void gla_c(const Frame& F, const bf16_t* __restrict__ PROJ, const bf16_t* __restrict__ OD, const float* __restrict__ ng, bf16_t* __restrict__ O) {
    const int gw = F.bid * NWAVES + F.wave, NGW = F.G * NWAVES, lane = F.lane;
    for (int row = gw; row < MTOK; row += NGW) {
        const u32x4* pf = (const u32x4*)(OD + (size_t)row * GLA_DV) + lane; const u32x4* pb = (const u32x4*)(OD + ((size_t)MTOK + row) * GLA_DV) + lane;
        const u32x4* pr = (const u32x4*)(PROJ + (size_t)row * GLA_NPAD + 4096) + lane;
        u32x4 a[4], bq[4], rw[4];
#pragma unroll
        for (int j = 0; j < 4; ++j) { a[j] = pf[64 * j]; bq[j] = pb[64 * j]; rw[j] = pr[64 * j]; }
        u32x4* po = (u32x4*)(O + (size_t)row * GLA_DV) + lane;
#pragma unroll
        for (int j = 0; j < 4; ++j) {
            float v[8];
            v[0] = bf_lo(a[j].x) + bf_lo(bq[j].x); v[1] = bf_hi(a[j].x) + bf_hi(bq[j].x); v[2] = bf_lo(a[j].y) + bf_lo(bq[j].y); v[3] = bf_hi(a[j].y) + bf_hi(bq[j].y);
            v[4] = bf_lo(a[j].z) + bf_lo(bq[j].z); v[5] = bf_hi(a[j].z) + bf_hi(bq[j].z); v[6] = bf_lo(a[j].w) + bf_lo(bq[j].w); v[7] = bf_hi(a[j].w) + bf_hi(bq[j].w);
            float ss = 0.f;
#pragma unroll
            for (int e = 0; e < 8; ++e) ss += v[e] * v[e];
            const float rstd = 1.0f / sqrtf(wave_sum(ss, lane) * (1.0f / GLA_DVH) + 1e-6f);
            const f32x4 g0 = *(const f32x4*)(ng + 8 * (lane + 64 * j)), g1 = *(const f32x4*)(ng + 8 * (lane + 64 * j) + 4);
            const float r[8] = {bf_lo(rw[j].x), bf_hi(rw[j].x), bf_lo(rw[j].y), bf_hi(rw[j].y), bf_lo(rw[j].z), bf_hi(rw[j].z), bf_lo(rw[j].w), bf_hi(rw[j].w)};
            float y[8];
#pragma unroll
            for (int e = 0; e < 8; ++e) { const float gg = e < 4 ? g0[e] : g1[e - 4]; y[e] = v[e] * rstd * gg * (r[e] * __builtin_amdgcn_rcpf(1.0f + __expf(-r[e]))); }
            u32x4 ow; ow.x = pk2(y[0], y[1]); ow.y = pk2(y[2], y[3]); ow.z = pk2(y[4], y[5]); ow.w = pk2(y[6], y[7]); po[64 * j] = ow; }
    }
}
__device__ __forceinline__ void dsa_norm(const Frame& F, bf16_t* __restrict__ QKV, const float* __restrict__ qn, const float* __restrict__ kn, const float* __restrict__ COS, const float* __restrict__ SIN) {
    const int gw = F.bid * NWAVES + F.wave, NGW = F.G * NWAVES, lane = F.lane, j = lane & 7;
    for (int row = gw; row < MTOK; row += NGW) {
        const int pos = row & (SEQ - 1);
        bf16_t* rp = QKV + (size_t)row * DSA_QKV + (lane >> 3) * DSA_HD + 8 * j;
        u32x4 w1[6], w2[6];
#pragma unroll
        for (int k = 0; k < 6; ++k) { w1[k] = *(const u32x4*)(rp + 8 * k * DSA_HD); w2[k] = *(const u32x4*)(rp + 8 * k * DSA_HD + 64); }
        const f32x4 c0 = *(const f32x4*)(COS + pos * 64 + 8 * j), c1 = *(const f32x4*)(COS + pos * 64 + 8 * j + 4), s0 = *(const f32x4*)(SIN + pos * 64 + 8 * j), s1 = *(const f32x4*)(SIN + pos * 64 + 8 * j + 4);
        const float cs[8] = {c0[0], c0[1], c0[2], c0[3], c1[0], c1[1], c1[2], c1[3]}, sn[8] = {s0[0], s0[1], s0[2], s0[3], s1[0], s1[1], s1[2], s1[3]};
#pragma unroll
        for (int k = 0; k < 6; ++k) {
            const float* gn = (k < 3 ? qn : kn) + (k % 3) * DSA_HD + 8 * j;
            const f32x4 g10 = *(const f32x4*)gn, g11 = *(const f32x4*)(gn + 4), g20 = *(const f32x4*)(gn + 64), g21 = *(const f32x4*)(gn + 68);
            const float g1[8] = {g10[0], g10[1], g10[2], g10[3], g11[0], g11[1], g11[2], g11[3]}, g2[8] = {g20[0], g20[1], g20[2], g20[3], g21[0], g21[1], g21[2], g21[3]};
            const unsigned a[4] = {w1[k].x, w1[k].y, w1[k].z, w1[k].w}, b[4] = {w2[k].x, w2[k].y, w2[k].z, w2[k].w};
            float x1[8], x2[8]; float ss = 0.f;
#pragma unroll
            for (int e = 0; e < 4; ++e) { x1[2 * e] = bf_lo(a[e]); x1[2 * e + 1] = bf_hi(a[e]); x2[2 * e] = bf_lo(b[e]); x2[2 * e + 1] = bf_hi(b[e]); }
#pragma unroll
            for (int e = 0; e < 8; ++e) ss += x1[e] * x1[e] + x2[e] * x2[e];
            ss += shx(ss, 1, lane); ss += shx(ss, 2, lane); ss += shx(ss, 4, lane);
            const float rstd = 1.0f / sqrtf(ss * (1.0f / DSA_HD) + 1e-6f), sc = (k < 3) ? 0.08838834764831845f : 1.0f;
            unsigned o1[4], o2[4];
#pragma unroll
            for (int e = 0; e < 4; ++e) { float r1[2], r2[2];
#pragma unroll
                for (int u = 0; u < 2; ++u) { const int i = 2 * e + u; const float y1 = x1[i] * rstd * g1[i], y2 = x2[i] * rstd * g2[i];
                    r1[u] = (y1 * cs[i] - y2 * sn[i]) * sc; r2[u] = (y2 * cs[i] + y1 * sn[i]) * sc; }
                o1[e] = pk2(r1[0], r1[1]); o2[e] = pk2(r2[0], r2[1]); }
            *(u32x4*)(rp + 8 * k * DSA_HD) = (u32x4){o1[0], o1[1], o1[2], o1[3]}; *(u32x4*)(rp + 8 * k * DSA_HD + 64) = (u32x4){o2[0], o2[1], o2[2], o2[3]};
        }
    }
}
constexpr int DSA_TP = 272, DSA_TROWS = 272;
struct DsaItem { int qbr, hd, g, b, dil, Ls, r, qb, i0, qcol; };
__device__ __forceinline__ DsaItem dsa_decode(int item0) {
    const int item = (item0 & ~255) + ((item0 & 7) * 32 + ((item0 & 255) >> 3));
    DsaItem d; d.qbr = item & 127; d.hd = (item >> 7) & 7; d.g = (item >> 10) % 3; d.b = item / 3072;
    d.dil = (d.g == 0) ? 1 : (d.g == 1) ? 4 : 16; d.Ls = SEQ / d.dil; const int nqb = d.Ls / 128; d.r = d.qbr / nqb; d.qb = d.qbr % nqb;
    d.i0 = 128 * d.qb - 64; d.qcol = (d.g * 8 + d.hd) * DSA_HD; return d;
}
__device__ __forceinline__ void dsa_attn(const Frame& F, const bf16_t* __restrict__ QKV, float* __restrict__ PO, float* __restrict__ LSE) {
    LAS unsigned char* Kt = F.lds;
    LAS unsigned char* Vt = F.lds + DSA_TROWS * DSA_TP;
    const int tid = F.tid, lane = F.lane, w = F.wave, i15 = lane & 15, kq = lane >> 4, qq = (lane & 15) >> 2, p = lane & 3;
    constexpr int NITEM = BATCH * DSA_G * DSA_H * 128;
    if (tid < 272) { const u32x4 z = {0u, 0u, 0u, 0u}; *(LAS u32x4*)(Kt + 256 * DSA_TP + 16 * tid) = z; *(LAS u32x4*)(Vt + 256 * DSA_TP + 16 * tid) = z; }
    u32x4 rk[8], rv[8]; bf16x8 Qn[4];
#define DSA_LOAD(it_) do { const DsaItem d_ = dsa_decode(it_); const bf16_t* Bb_ = QKV + (size_t)d_.b * SEQ * DSA_QKV; \
        _Pragma("unroll") for (int k8 = 0; k8 < 8; ++k8) { const int q_ = tid + 512 * k8, jj = q_ >> 4, ch = q_ & 15, i = d_.i0 + jj; const bool valid = (i >= 0) && (i < d_.Ls); \
            rk[k8] = (u32x4){0u, 0u, 0u, 0u}; rv[k8] = (u32x4){0u, 0u, 0u, 0u}; \
            if (valid) { const bf16_t* src = Bb_ + (size_t)(d_.r + d_.dil * i) * DSA_QKV + d_.qcol + 8 * ch; rk[k8] = *(const u32x4*)(src + 3072); rv[k8] = *(const u32x4*)(src + 6144); } } \
        const int qpos_ = d_.r + d_.dil * (128 * d_.qb + 16 * w + i15); \
        _Pragma("unroll") for (int ks = 0; ks < 4; ++ks) Qn[ks] = *(const bf16x8*)(Bb_ + (size_t)qpos_ * DSA_QKV + d_.qcol + 32 * ks + 8 * kq); } while (0)
    if (F.bid < NITEM) DSA_LOAD(F.bid);
    for (int item = F.bid; item < NITEM; item += F.G) {
        const DsaItem d = dsa_decode(item);
        const int i0 = d.i0, Ls = d.Ls;
        const int qi = 128 * d.qb + 16 * w + i15, qpos = d.r + d.dil * qi;
        __syncthreads();
#pragma unroll
        for (int k8 = 0; k8 < 8; ++k8) { const int q_ = tid + 512 * k8, jj = q_ >> 4, ch = q_ & 15;
            *(LAS u32x4*)(Kt + jj * DSA_TP + 16 * ch) = rk[k8]; *(LAS u32x4*)(Vt + jj * DSA_TP + 16 * ch) = rv[k8]; }
        bf16x8 Qf[4];
#pragma unroll
        for (int ks = 0; ks < 4; ++ks) Qf[ks] = Qn[ks];
        __syncthreads();
        if (item + F.G < NITEM) DSA_LOAD(item + F.G);
        f32x4 sa[10];
#pragma unroll
        for (int cb = 0; cb < 10; ++cb) { sa[cb] = (f32x4){0.f, 0.f, 0.f, 0.f};
#pragma unroll
            for (int ks = 0; ks < 4; ++ks) { const bf16x8 Af = *(const LAS bf16x8*)(Kt + (16 * (w + cb) + i15) * DSA_TP + (32 * ks + 8 * kq) * 2);
                sa[cb] = __builtin_amdgcn_mfma_f32_16x16x32_bf16(Af, Qf[ks], sa[cb], 0, 0, 0); } }
        float m = -1e30f;
#pragma unroll
        for (int cb = 0; cb < 10; ++cb)
#pragma unroll
            for (int e = 0; e < 4; ++e) { const int jrel = 16 * cb + 4 * kq + e - i15, ki = i0 + 16 * (w + cb) + 4 * kq + e;
                const bool ok = (jrel >= 0) && (jrel <= 128) && (ki >= 0) && (ki < Ls);
                sa[cb][e] = ok ? sa[cb][e] : -1e30f; m = fmaxf(m, sa[cb][e]); }
        m = fmaxf(m, shx(m, 16, lane)); m = fmaxf(m, shx(m, 32, lane));
        float l = 0.f;
#pragma unroll
        for (int cb = 0; cb < 10; ++cb)
#pragma unroll
            for (int e = 0; e < 4; ++e) { const float pe = __expf(sa[cb][e] - m); sa[cb][e] = pe; l += pe; }
        l += shx(l, 16, lane); l += shx(l, 32, lane);
        f32x4 oa[8];
#pragma unroll
        for (int db = 0; db < 8; ++db) oa[db] = (f32x4){0.f, 0.f, 0.f, 0.f};
        unsigned vtb = lds_addr(Vt + (16 * w + 4 * kq + qq) * DSA_TP + (4 * p) * 2); asm volatile("" : "+v"(vtb));
#pragma unroll
        for (int s5 = 0; s5 < 5; ++s5) {
            u32x4 pw; pw.x = pk2(sa[2 * s5][0], sa[2 * s5][1]); pw.y = pk2(sa[2 * s5][2], sa[2 * s5][3]); pw.z = pk2(sa[2 * s5 + 1][0], sa[2 * s5 + 1][1]); pw.w = pk2(sa[2 * s5 + 1][2], sa[2 * s5 + 1][3]);
            const bf16x8 Pf = __builtin_bit_cast(bf16x8, pw);
#pragma unroll
            for (int dq = 0; dq < 2; ++dq) {
                bf16x4 t0, t1, t2, t3, t4, t5, t6, t7;
                const unsigned a0 = vtb + (32 * s5) * DSA_TP + (64 * dq) * 2, a1 = a0 + 16 * DSA_TP;
                asm volatile("ds_read_b64_tr_b16 %0, %8\n\tds_read_b64_tr_b16 %1, %9\n\tds_read_b64_tr_b16 %2, %8 offset:32\n\tds_read_b64_tr_b16 %3, %9 offset:32\n\t"
                             "ds_read_b64_tr_b16 %4, %8 offset:64\n\tds_read_b64_tr_b16 %5, %9 offset:64\n\tds_read_b64_tr_b16 %6, %8 offset:96\n\tds_read_b64_tr_b16 %7, %9 offset:96\n\ts_waitcnt lgkmcnt(0)"
                             : "=&v"(t0), "=&v"(t1), "=&v"(t2), "=&v"(t3), "=&v"(t4), "=&v"(t5), "=&v"(t6), "=&v"(t7) : "v"(a0), "v"(a1) : "memory");
                oa[4 * dq + 0] = __builtin_amdgcn_mfma_f32_16x16x32_bf16(tr_join(t0, t1), Pf, oa[4 * dq + 0], 0, 0, 0);
                oa[4 * dq + 1] = __builtin_amdgcn_mfma_f32_16x16x32_bf16(tr_join(t2, t3), Pf, oa[4 * dq + 1], 0, 0, 0);
                oa[4 * dq + 2] = __builtin_amdgcn_mfma_f32_16x16x32_bf16(tr_join(t4, t5), Pf, oa[4 * dq + 2], 0, 0, 0);
                oa[4 * dq + 3] = __builtin_amdgcn_mfma_f32_16x16x32_bf16(tr_join(t6, t7), Pf, oa[4 * dq + 3], 0, 0, 0);
            } }
        const float inv = 1.0f / l;
        float* orow = PO + ((size_t)d.g * MTOK + (size_t)d.b * SEQ + qpos) * DSA_OUT + d.hd * DSA_HD + 4 * kq;
#pragma unroll
        for (int db = 0; db < 8; ++db) *(f32x4*)(orow + 16 * db) = oa[db] * inv;
        if (kq == 0) LSE[(((size_t)d.g * BATCH + d.b) * DSA_H + d.hd) * SEQ + (size_t)d.r * Ls + qi] = m + __logf(l);
    }
#undef DSA_LOAD
    __syncthreads();
}
__device__ __forceinline__ void dsa_merge(const Frame& F, const float* __restrict__ PO, const float* __restrict__ LSE, bf16_t* __restrict__ O) {
    const size_t n8 = (size_t)MTOK * DSA_OUT / 8;
    for (size_t i = (size_t)F.bid * NTHREADS + F.tid; i < n8; i += (size_t)F.G * NTHREADS) {
        const size_t row = i >> 7; const int hd = (int)(i & 127) >> 4;
        const int bb = (int)(row >> 14), pos = (int)(row & (SEQ - 1));
        const float l0 = LSE[(((size_t)0 * BATCH + bb) * DSA_H + hd) * SEQ + pos];
        const float l1 = LSE[(((size_t)1 * BATCH + bb) * DSA_H + hd) * SEQ + (size_t)(pos & 3) * (SEQ / 4) + (pos >> 2)];
        const float l2 = LSE[(((size_t)2 * BATCH + bb) * DSA_H + hd) * SEQ + (size_t)(pos & 15) * (SEQ / 16) + (pos >> 4)];
        const float mx = fmaxf(l0, fmaxf(l1, l2));
        float w0 = __expf(l0 - mx), w1 = __expf(l1 - mx), w2 = __expf(l2 - mx); const float inv = 1.0f / (w0 + w1 + w2); w0 *= inv; w1 *= inv; w2 *= inv;
        const f32x4* p0 = (const f32x4*)(PO + i * 8); const f32x4* p1 = (const f32x4*)(PO + (size_t)MTOK * DSA_OUT + i * 8); const f32x4* p2 = (const f32x4*)(PO + (size_t)2 * MTOK * DSA_OUT + i * 8);
        const f32x4 a = p0[0] * w0 + p1[0] * w1 + p2[0] * w2, bq = p0[1] * w0 + p1[1] * w1 + p2[1] * w2;
        u32x4 o; o.x = pk2(a[0], a[1]); o.y = pk2(a[2], a[3]); o.z = pk2(bq[0], bq[1]); o.w = pk2(bq[2], bq[3]);
        *(u32x4*)(O + i * 8) = o;
    }
}
#ifndef MK_PER_PHASE
#define MK_PER_PHASE 0
#endif
constexpr int N_PHASES = DEPTH * 13;
#ifndef XCC_VB
#define XCC_VB 1
#endif
#ifndef WGM_SWIGLU
#define WGM_SWIGLU 4
#endif
#ifndef WGM_BF16
#define WGM_BF16 4
#endif
#ifndef WGM_RES
#define WGM_RES 4
#endif
#ifndef WGM_GLU
#define WGM_GLU 4
#endif
#ifndef PROBE_MASK
#define PROBE_MASK 0
#endif
#define REP(bit) for (int rep_ = 0; rep_ < ((PROBE_MASK & (bit)) ? 2 : 1); ++rep_, __syncthreads())
#define GAS __attribute__((address_space(1)))
struct Args { const GAS float* in[28]; GAS float* out; GAS unsigned char* ws; int ph_lo, ph_hi; float rope_inv[64]; };
struct ArgsH { const void* in[28]; void* out; void* ws; int ph_lo, ph_hi; float rope_inv[64]; };
static_assert(sizeof(ArgsH) == 28 * 8 + 8 + 8 + 4 + 4 + 256, "Args layout");
enum { I_X = 0, I_C, I_ADAW, I_ADAB, I_NORMG, I_F1I, I_F1O, I_F2I, I_F2O, I_SWIN, I_SLRE, I_SLIM, I_SLDT, I_SBRE, I_SBIM, I_SCRE, I_SCIM, I_SD, I_SWOUT,
       I_GWIN, I_GWG, I_GBG, I_GNG, I_GWO, I_DWIN, I_DQN, I_DKN, I_DWO };

__device__ __forceinline__ bool relaunder(Frame& F, int wave0) {
    int l_; asm volatile("v_mbcnt_lo_u32_b32 %0, -1, 0\n\tv_mbcnt_hi_u32_b32 %0, -1, %0" : "=v"(l_));
    int w_ = wave0; asm volatile("" : "+s"(w_));
    F.lane = l_; F.wave = w_; F.tid = w_ * 64 + l_;
    int b_ = __builtin_amdgcn_readfirstlane((int)((volatile LAS unsigned*)(F.lds + LDS_MISC))[5]), g_ = gridDim.x; asm volatile("" : "+s"(b_), "+s"(g_)); F.bid = b_; F.G = g_; return true;
}
__device__ __forceinline__ void lds_nan(const Frame& F) {
    const u32x4 nv = {0xffffffffu, 0xffffffffu, 0xffffffffu, 0xffffffffu};
    for (int i = F.tid; i < 131072 / 16; i += NTHREADS) *(LAS u32x4*)(F.lds + 16 * i) = nv;
    __syncthreads();
}
__device__ __forceinline__ const Args* args_ptr() { const Args* p = (const Args*)__builtin_amdgcn_kernarg_segment_ptr(); asm volatile("" : "+s"(p)); return p; }
__global__ void __launch_bounds__(NTHREADS, 2) fwd(Args a) {
    extern __shared__ __attribute__((aligned(16))) unsigned char lds_raw[];
    Frame F;
    F.lds = (LAS unsigned char*)lds_raw; F.tid = threadIdx.x; F.lane = F.tid & 63; F.wave = __builtin_amdgcn_readfirstlane(F.tid >> 6); F.G = gridDim.x; F.bid = blockIdx.x;
#if (PROBE_MASK & 32768)
    for (int i_ = F.tid; i_ < LDS_MISC / 4; i_ += NTHREADS) ((LAS unsigned*)F.lds)[i_] = 0xffffffffu;
#endif
    if (F.tid < 16) ((LAS unsigned*)(F.lds + LDS_MISC))[F.tid] = 0u;
    __syncthreads();
    unsigned char* ws0 = (unsigned char*)a.ws;
    XcdBarrier bar; bar.bar = (unsigned*)(ws0 + WS_CTL); bar.x = 0; bar.st = (volatile LAS unsigned*)(F.lds + LDS_MISC);
    if (!MK_PER_PHASE) bar = xcd_barrier_post((unsigned*)(ws0 + WS_CTL), (volatile LAS unsigned*)(F.lds + LDS_MISC));
    if (F.tid == 0) { volatile LAS unsigned* M_ = (volatile LAS unsigned*)(F.lds + LDS_MISC); const unsigned xcc_ = xb_xcc_id();
        const unsigned rk_ = __hip_atomic_fetch_add((unsigned*)(ws0 + WS_CTL) + 8704 + 64 * xcc_, 1u, __ATOMIC_RELAXED, __HIP_MEMORY_SCOPE_AGENT); M_[4] = rk_ * 8u + xcc_; M_[5] = blockIdx.x; }
    __syncthreads();
    const int lo = a.ph_lo, hi = a.ph_hi, wave0 = F.wave;
    int ph = 0;
#define PH_ON (ph >= lo && ph < hi && relaunder(F, wave0))
#define PH_END do { if (!MK_PER_PHASE && ph >= lo && ph + 1 < hi) { XcdBarrier b2_ = bar; asm volatile("" : "+s"(b2_.bar)); xcd_barrier(b2_); if (PROBE_MASK & 262144) xcd_barrier(b2_); if (ph == 0 && XCC_VB) { if (threadIdx.x == 0) { volatile LAS unsigned* M_ = (volatile LAS unsigned*)(F.lds + LDS_MISC); bool ok_ = gridDim.x == 256; for (int x_ = 0; x_ < 8; ++x_) ok_ = ok_ && __hip_atomic_load(b2_.bar + 8704 + 64 * x_, __ATOMIC_RELAXED, __HIP_MEMORY_SCOPE_AGENT) == 32u; if (ok_) M_[5] = M_[4]; } __syncthreads(); } } if (PROBE_MASK & 65536) { relaunder(F, wave0); lds_nan(F); } ++ph; } while (0)

#define AP (args_ptr())
#define WS(off) ((unsigned char*)(AP->ws + (off)))
#define X ((float*)(AP->out))
#define MOD ((float*)WS(WS_MOD))
#define COS ((float*)WS(WS_COS))
#define SIN ((float*)WS(WS_SIN))
#define W1I ((bf16_t*)WS(WS_W1I))
#define W1O ((bf16_t*)WS(WS_W1O))
#define W2I ((bf16_t*)WS(WS_W2I))
#define W2O ((bf16_t*)WS(WS_W2O))
#define WMI ((bf16_t*)WS(WS_WMI))
#define WMO ((bf16_t*)WS(WS_WMO))
#define H ((bf16_t*)WS(WS_H))
#define B1 ((bf16_t*)WS(WS_B1))
#define IN(i) ((const float*)(AP->in[i]))
    constexpr int NCOL = NMOD * D;

#define CONVERT_LAYER_WEIGHTS() do { convert_matrix<1>(F, IN(I_F1I) + (size_t)layer * D * 2 * DFF, D, 2 * DFF, W1I, DFF); convert_matrix<0>(F, IN(I_F1O) + (size_t)layer * DFF * D, DFF, D, W1O, 0); convert_matrix<1>(F, IN(I_F2I) + (size_t)layer * D * 2 * DFF, D, 2 * DFF, W2I, DFF); convert_matrix<0>(F, IN(I_F2O) + (size_t)layer * DFF * D, DFF, D, W2O, 0); if (kind == 0) { convert_matrix<0>(F, IN(I_SWIN) + (size_t)jm * D * D, D, D, WMI, 0); convert_matrix<1>(F, IN(I_SWOUT) + (size_t)jm * D * 2 * D, D, 2 * D, WMO, D); } else if (kind == 1) { convert_matrix<0>(F, IN(I_GWIN) + (size_t)jm * D * GLA_NPROJ, D, GLA_NPROJ, WMI, 0); zero_bf16(F, WMI + (size_t)GLA_NPROJ * D, (size_t)(GLA_NPAD - GLA_NPROJ) * D / 8); convert_matrix<0>(F, IN(I_GWO) + (size_t)jm * GLA_DV * D, GLA_DV, D, WMO, 0); } else { convert_matrix<0>(F, IN(I_DWIN) + (size_t)jm * D * DSA_QKV, D, DSA_QKV, WMI, 0); convert_matrix<0>(F, IN(I_DWO) + (size_t)jm * DSA_OUT * D, DSA_OUT, D, WMO, 0); } } while (0)
#pragma unroll 1
    for (int layer = 0; layer < DEPTH; ++layer) {
        const int kind = layer % 3, jm = layer / 3;
#define modl (MOD + (size_t)layer * BATCH * NCOL)
        if (layer == 0) {
        if (PH_ON) REP(32) {
            if (layer == 0) { REP(128) mod_phase(F, IN(I_C), IN(I_ADAW), IN(I_ADAB), MOD); REP(4096) rope_phase(F, AP->rope_inv, COS, SIN); }
            if (layer == 0 && (PROBE_MASK & 8192)) { float acc_ = (float)F.tid; const unsigned long long t0_ = __builtin_amdgcn_s_memrealtime(); while (__builtin_amdgcn_s_memrealtime() - t0_ < 30000ull) { _Pragma("unroll") for (int i_ = 0; i_ < 64; ++i_) acc_ = __builtin_fmaf(acc_, 1.0001f, 0.5f); } if (acc_ == 12345.678f) ((float*)WS(WS_B2))[F.tid] = acc_; __syncthreads(); }
            if (layer == 0 && (PROBE_MASK & 16384)) { f32x4 acc_ = {0.f, 0.f, 0.f, 0.f}; const f32x4* src_ = (const f32x4*)IN(I_F2I); for (size_t i_ = (size_t)F.bid * NTHREADS + F.tid; i_ < (size_t)20 * 1024 * 1024; i_ += (size_t)F.G * NTHREADS) acc_ += src_[i_]; if (acc_[0] + acc_[1] + acc_[2] + acc_[3] == 12345.678f) ((float*)WS(WS_B2))[F.tid] = acc_[0]; __syncthreads(); }
            if (layer == 0 && (PROBE_MASK & 1024)) { const unsigned long long t0_ = __builtin_amdgcn_s_memrealtime(); while (__builtin_amdgcn_s_memrealtime() - t0_ < 25000ull) __builtin_amdgcn_s_sleep(8); __syncthreads(); }
            if ((PROBE_MASK >> 20) && layer == (PROBE_MASK >> 20)) { __syncthreads(); mod_phase(F, IN(I_C), IN(I_ADAW), IN(I_ADAB), (float*)WS(WS_B2)); __syncthreads(); }
            if (layer == 0 && (PROBE_MASK & 512)) { __syncthreads(); mod_phase(F, IN(I_C), IN(I_ADAW), IN(I_ADAB), (float*)WS(WS_B2)); rope_phase(F, AP->rope_inv, (float*)WS(WS_B2 + 8 * MiB), (float*)WS(WS_B2 + 16 * MiB)); __syncthreads(); }
            if (layer == 0) CONVERT_LAYER_WEIGHTS();
        }
        PH_END;
        }
#pragma unroll 1
        for (int s = 0; s < 3; ++s) {
#define Xsrc ((layer == 0 && s == 0) ? IN(I_X) : (const float*)X)
#if (PROBE_MASK >> 20) >= 16 && (PROBE_MASK >> 20) < 20
            if (layer == 3 && s == (PROBE_MASK >> 20) - 16 && relaunder(F, wave0)) { mod_phase(F, IN(I_C), IN(I_ADAW), IN(I_ADAB), (float*)WS(WS_END - 2 * MiB)); __syncthreads(); }
#endif
            if (PH_ON) REP(1) { if (layer > 0 && s == 0) CONVERT_LAYER_WEIGHTS();
                norm_phase(F, Xsrc, IN(I_NORMG) + (size_t)(layer * 3 + s) * D, modl + (3 * s) * D, modl + (3 * s + 1) * D, NCOL, H, (layer == 0 && s == 0) ? (float*)X : (float*)nullptr); }
            PH_END;
            const int nin = (s != 1) ? 2 * DFF : (kind == 0 ? D : kind == 1 ? GLA_NPAD : DSA_QKV);
            if (PH_ON) {
                if (s != 1) for (int rep_ = 0; rep_ < ((PROBE_MASK & (16 | 2048)) ? 2 : 1); ++rep_, __syncthreads()) { relaunder(F, wave0); pg8::Gemm g{H, (s == 0) ? W1I : W2I, MTOK, 2 * DFF, D}; pg8::StaticOrder S; S.init(MTOK, 2 * DFF, F.G, F.bid, WGM_SWIGLU);
                    pg8::EpiSwiGLU E{((PROBE_MASK & 2048) && rep_) ? (bf16_t*)WS(WS_B2) : B1, DFF}; pg8::gemm_phase<pg8::EpiSwiGLU, pg8::StaticOrder, true, true>(F.lds, g, S, E, F.tid); }
                else { pg8::Gemm g{H, WMI, MTOK, nin, D}; pg8::StaticOrder S; S.init(MTOK, nin, F.G, F.bid, WGM_BF16);
                    pg8::EpiBf16P E{B1, nin}; pg8::gemm_phase<pg8::EpiBf16P, pg8::StaticOrder, true, true>(F.lds, g, S, E, F.tid); }
            }
            PH_END;
#if (PROBE_MASK & 2048)
                if (s != 1 && relaunder(F, wave0)) {
                    pg8::StaticOrder S; S.init(MTOK, 2 * DFF, F.G, F.bid, WGM_SWIGLU); pg8::Unit u_; unsigned bad_ = 0;
                    for (int i_ = 0; S.next(i_, u_); ++i_) for (int q_ = F.tid; q_ < 256 * 16; q_ += NTHREADS) { const int r_ = u_.pm * 256 + (q_ >> 4), c_ = u_.pn * 128 + (q_ & 15) * 8;
                        const u32x4 a_ = *(const u32x4*)(B1 + (size_t)r_ * DFF + c_), b_ = *(const u32x4*)((bf16_t*)WS(WS_B2) + (size_t)r_ * DFF + c_);
                        bad_ += (a_.x != b_.x) | (a_.y != b_.y) | (a_.z != b_.z) | (a_.w != b_.w); }
                    if (bad_) atomicAdd((unsigned*)WS(WS_CTL) + 8192, bad_); }
#endif
            if (s == 1) {
                if (kind == 0) {

                    if (PH_ON) REP(2) s5_pass1(F, jm, B1, IN(I_SLRE), IN(I_SLIM), IN(I_SLDT), IN(I_SBRE), IN(I_SBIM), (float*)WS(WS_S5E));
                    PH_END;
                    if (PH_ON) REP(2) s5_scan<2>(F, jm, B1, IN(I_SLRE), IN(I_SLIM), IN(I_SLDT), IN(I_SBRE), IN(I_SBIM), IN(I_SCRE), IN(I_SCIM), (float*)WS(WS_S5E), (bf16_t*)WS(S5_YF), (bf16_t*)WS(S5_YB));
                    PH_END;
                    if (PH_ON) REP(64) s5_post(F, (bf16_t*)WS(S5_YF), (bf16_t*)WS(S5_YB), B1, IN(I_SD) + (size_t)jm * D, H);
                    PH_END;
                } else if (kind == 1) {

                    if (PH_ON) REP(4) gla_a(F, jm, B1, IN(I_GWG), IN(I_GBG), (bf16_t*)WS(GLA_QD), (bf16_t*)WS(GLA_KL), (bf16_t*)WS(GLA_ATT), (float*)WS(GLA_DEC));
                    PH_END;
                    if (PH_ON) REP(4) { gla_b<1>(F, B1, (bf16_t*)WS(GLA_QD), (bf16_t*)WS(GLA_KL), (bf16_t*)WS(GLA_ATT), (float*)WS(GLA_DEC), (bf16_t*)WS(GLA_OD), (float*)WS(WS_H));
                        { asm volatile("s_waitcnt vmcnt(0)" ::: "memory"); __syncthreads(); XcdBarrier b4_ = bar; asm volatile("" : "+s"(b4_.bar)); xcd_barrier(b4_); relaunder(F, wave0); }
                        gla_b<2>(F, B1, (bf16_t*)WS(GLA_QD), (bf16_t*)WS(GLA_KL), (bf16_t*)WS(GLA_ATT), (float*)WS(GLA_DEC), (bf16_t*)WS(GLA_OD), (float*)WS(WS_H)); }
                    PH_END;
                    if (PH_ON) REP(64) gla_c(F, B1, (bf16_t*)WS(GLA_OD), IN(I_GNG) + (size_t)jm * GLA_DV, H);
                    PH_END;
                } else {

                    if (PH_ON) dsa_norm(F, B1, IN(I_DQN) + (size_t)jm * DSA_G * DSA_HD, IN(I_DKN) + (size_t)jm * DSA_G * DSA_HD, COS, SIN);
                    PH_END;
                    if (PH_ON) REP(8) dsa_attn(F, B1, (float*)WS(DSA_PO), (float*)WS(DSA_LSE));
                    PH_END;
                    if (PH_ON) REP(64) dsa_merge(F, (float*)WS(DSA_PO), (float*)WS(DSA_LSE), H);
                    PH_END;
                }
            }
#if (PROBE_MASK >> 20) == 20
            if (layer == 3 && s == 2 && relaunder(F, wave0)) { mod_phase(F, IN(I_C), IN(I_ADAW), IN(I_ADAB), (float*)WS(WS_END - 2 * MiB)); __syncthreads(); }
#endif
            if (PH_ON) {
                if (s == 1 && kind == 0) { pg8::Gemm g{H, WMO, MTOK, 2 * D, D}; pg8::StaticOrder S; S.init(MTOK, 2 * D, F.G, F.bid, WGM_GLU);
                    pg8::EpiGLURes E{X, D, modl + 5 * D, NCOL, SEQ}; pg8::gemm_phase<pg8::EpiGLURes, pg8::StaticOrder, true, true>(F.lds, g, S, E, F.tid); }
                else { const int kout = (s != 1) ? DFF : (kind == 1 ? GLA_DV : DSA_OUT);
#if (PROBE_MASK & 131072)
                    const int nrep_ = (layer == 3 && s == 2) ? 3 : 1;
                    for (int rep_ = 0; rep_ < nrep_; ++rep_) { relaunder(F, wave0);
                    float* outp_ = (nrep_ == 3 && rep_ < 2) ? (float*)WS(WS_B2 + (size_t)rep_ * 256 * MiB) : X;
                    if (nrep_ == 3 && rep_ < 2) { pg8::StaticOrder S; S.init(MTOK, D, F.G, F.bid, WGM_RES); pg8::Unit u_;
                        for (int i_ = 0; S.next(i_, u_); ++i_) for (int q_ = F.tid; q_ < 256 * 64; q_ += NTHREADS) { const size_t o_ = (size_t)(u_.pm * 256 + (q_ >> 6)) * D + u_.pn * 256 + (q_ & 63) * 4;
                            *(u32x4*)(outp_ + o_) = *(const u32x4*)(X + o_); }
                        asm volatile("s_waitcnt vmcnt(0)" ::: "memory"); __syncthreads(); relaunder(F, wave0); }
                    if (nrep_ == 3 && rep_ == 1) { mod_phase(F, IN(I_C), IN(I_ADAW), IN(I_ADAB), (float*)WS(WS_END - 2 * MiB)); __syncthreads(); relaunder(F, wave0); }
                    { pg8::Gemm g{(s != 1) ? (const bf16_t*)B1 : (const bf16_t*)H, (s == 0) ? W1O : (s == 2) ? W2O : WMO, MTOK, D, kout}; pg8::StaticOrder S; S.init(MTOK, D, F.G, F.bid, WGM_RES);
                    pg8::EpiRes E{outp_, D, modl + (3 * s + 2) * D, NCOL, (s != 1) ? 0.5f : 1.0f, SEQ}; pg8::gemm_phase<pg8::EpiRes, pg8::StaticOrder, true, true>(F.lds, g, S, E, F.tid); }
                    asm volatile("s_waitcnt vmcnt(0)" ::: "memory"); __syncthreads();
                    if (nrep_ == 3 && rep_ == 1) { relaunder(F, wave0); pg8::StaticOrder S; S.init(MTOK, D, F.G, F.bid, WGM_RES); pg8::Unit u_; unsigned bad_ = 0;
                        const float* y1_ = (const float*)WS(WS_B2); const float* y2_ = (const float*)WS(WS_B2 + (size_t)256 * MiB);
                        for (int i_ = 0; S.next(i_, u_); ++i_) for (int q_ = F.tid; q_ < 256 * 64; q_ += NTHREADS) { const size_t o_ = (size_t)(u_.pm * 256 + (q_ >> 6)) * D + u_.pn * 256 + (q_ & 63) * 4;
                            const u32x4 a_ = *(const u32x4*)(y1_ + o_), b_ = *(const u32x4*)(y2_ + o_); bad_ += (a_.x != b_.x) + (a_.y != b_.y) + (a_.z != b_.z) + (a_.w != b_.w); }
                        if (bad_) atomicAdd((unsigned*)WS(WS_CTL) + 8192, bad_); __syncthreads(); }
                    } }
#else
                    for (int rep_ = ((PROBE_MASK & 524288) ? 0 : 1); rep_ < 2; ++rep_) { relaunder(F, wave0);
                    pg8::Gemm g{(s != 1) ? (const bf16_t*)B1 : (const bf16_t*)H, (s == 0) ? W1O : (s == 2) ? W2O : WMO, MTOK, D, kout}; pg8::StaticOrder S; S.init(MTOK, D, F.G, F.bid, WGM_RES);
                    pg8::EpiRes E{X, D, modl + (3 * s + 2) * D, NCOL, rep_ ? ((s != 1) ? 0.5f : 1.0f) : 0.0f, SEQ}; pg8::gemm_phase<pg8::EpiRes, pg8::StaticOrder, true, true>(F.lds, g, S, E, F.tid); __syncthreads(); } }
#endif
            }
            PH_END;
        }
    }
#if (PROBE_MASK & (2048 | 131072))
    { asm volatile("s_waitcnt vmcnt(0)" ::: "memory"); __syncthreads(); XcdBarrier b2_ = bar; xcd_barrier(b2_);
      const unsigned nb_ = __hip_atomic_load((unsigned*)WS(WS_CTL) + 8192, __ATOMIC_RELAXED, __HIP_MEMORY_SCOPE_AGENT);
      relaunder(F, wave0); if (nb_ && F.bid == 0 && F.tid < 64) X[F.tid] = __builtin_nanf(""); }
#endif
#undef PH_ON
#undef PH_END
#undef CONVERT_LAYER_WEIGHTS
#undef AP
#undef WS
#undef X
#undef MOD
#undef COS
#undef SIN
#undef W1I
#undef W1O
#undef W2I
#undef W2O
#undef WMI
#undef WMO
#undef H
#undef B1
#undef IN
#undef modl
#undef Xsrc
}

extern "C" void kernel_launch(void* const* d_in, const int* in_sizes, int n_in, void* d_out, int out_size, void* d_ws, size_t ws_size, hipStream_t stream) {
    static int grid = 0;
    if (grid == 0) {
        if (n_in != 28 || in_sizes[0] != MTOK * D || out_size != MTOK * D || ws_size < WS_END) {
            fprintf(stderr, "kernel_launch: unexpected problem (n_in %d, in0 %d, out %d, ws %zu < %zu?); nothing launched\n", n_in, n_in > 0 ? in_sizes[0] : -1, out_size, ws_size, (size_t)WS_END); grid = -1; return; }
        int dev = 0, cus = 0, per_cu = 0;
        if (hipGetDevice(&dev) != hipSuccess || hipDeviceGetAttribute(&cus, hipDeviceAttributeMultiprocessorCount, dev) != hipSuccess) { grid = -1; return; }
        if (hipFuncSetAttribute((const void*)fwd, hipFuncAttributeMaxDynamicSharedMemorySize, LDS_BYTES) != hipSuccess) { fprintf(stderr, "kernel_launch: hipFuncSetAttribute failed\n"); grid = -1; return; }
        if (hipOccupancyMaxActiveBlocksPerMultiprocessor(&per_cu, (const void*)fwd, NTHREADS, LDS_BYTES) != hipSuccess || per_cu < 1) { fprintf(stderr, "kernel_launch: occupancy query says %d blocks per CU\n", per_cu); }
        (void)hipGetLastError();
        if (cus < 256) { fprintf(stderr, "kernel_launch: built for a 256-CU device (MI355X), found %d CUs; nothing launched\n", cus); grid = -1; return; }
        grid = 256;
    }
    if (grid < 0) return;
    if (hipMemsetAsync((char*)d_ws + WS_CTL, 0, CTL_ZERO_BYTES, stream) != hipSuccess) return;
#if (PROBE_MASK & 32768)
    (void)hipMemsetAsync((char*)d_ws + WS_MOD, 0xFF, WS_END - WS_MOD, stream); (void)hipMemsetAsync(d_out, 0xFF, (size_t)MTOK * D * 4, stream);
#endif
    ArgsH a{};
    for (int i = 0; i < 28; ++i) a.in[i] = d_in[i];
    a.out = d_out; a.ws = d_ws;
    for (int j = 0; j < 64; ++j) a.rope_inv[j] = (float)pow(10000.0, -(double)j / 64.0);
#if MK_PER_PHASE
    for (int p = 0; p < N_PHASES; ++p) { a.ph_lo = p; a.ph_hi = p + 1; void* kargs[] = {&a}; (void)hipLaunchKernel((const void*)fwd, dim3(grid), dim3(NTHREADS), kargs, LDS_BYTES, stream); }
#else
    a.ph_lo = 0; a.ph_hi = N_PHASES;
    void* kargs[] = {&a};
    if (hipLaunchKernel((const void*)fwd, dim3(grid), dim3(NTHREADS), kargs, LDS_BYTES, stream) != hipSuccess) fprintf(stderr, "kernel_launch: launch failed\n");
#endif
}
```
